# Optimizing an MI355X kernel written in HIP

```python
import jax, jax.numpy as jnp
from jax import lax
import numpy as np

D_MODEL = 1024
BATCH = 2
SEQ = 8192
DEPTH = 4
DEC_BATCH = 16
DEC_SEQ = 2048
PAST_LEN = 128

GRID_W = 64
ROPE_THETA = 10000.0
NORM_EPS = 1e-6

ATTN_HEADS = 8
ATTN_KV_HEADS = 2
ATTN_GROUP = ATTN_HEADS // ATTN_KV_HEADS
ATTN_HEAD_DIM = 64
ATTN_Q_WIDTH = ATTN_HEADS * ATTN_HEAD_DIM
ATTN_KV_WIDTH = ATTN_KV_HEADS * ATTN_HEAD_DIM
QUERY_BLOCK = 128

MLSTM_HEADS = 4
MLSTM_HEAD_DIM = 128
MLSTM_WIDTH = MLSTM_HEADS * MLSTM_HEAD_DIM
MLSTM_CHUNK = 128
MLSTM_GATES = 4 * MLSTM_HEADS

AB_SIZES = (ATTN_Q_WIDTH, ATTN_KV_WIDTH, ATTN_KV_WIDTH,
            MLSTM_WIDTH, MLSTM_WIDTH, MLSTM_WIDTH, MLSTM_WIDTH, MLSTM_GATES)
AB_IN_COLS = sum(AB_SIZES)
AB_SPLIT_POINTS = tuple(int(p) for p in np.cumsum(AB_SIZES)[:-1])
AB_MIX_WIDTH = ATTN_Q_WIDTH + MLSTM_WIDTH

RET_HEADS = 4
RET_QK_DIM = 256
RET_V_DIM = 512
RET_QK_WIDTH = RET_HEADS * RET_QK_DIM
RET_V_WIDTH = RET_HEADS * RET_V_DIM
RET_CHUNK = 128
RET_SIZES = (RET_QK_WIDTH, RET_QK_WIDTH, RET_V_WIDTH, RET_V_WIDTH)
RET_IN_COLS = sum(RET_SIZES)
RET_SPLIT_POINTS = tuple(int(p) for p in np.cumsum(RET_SIZES)[:-1])

D_FF = 2816
CONV_WIDTH = 3

N_AB_LAYERS = (DEPTH + 1) // 2
N_RET_LAYERS = DEPTH // 2

kernel_name = 'hybrid_bidir_attn_mlstm_retention_convffn'


def rms_norm(x, gain):
    xf = x.astype(jnp.float32)
    y = xf * lax.rsqrt(jnp.mean(xf * xf, axis=-1, keepdims=True) + NORM_EPS)
    return (y * gain.astype(jnp.float32)).astype(x.dtype)


def head_rms_norm(x, gain):
    xf = x.astype(jnp.float32)
    return xf * lax.rsqrt(jnp.mean(xf * xf, axis=-1, keepdims=True) + NORM_EPS) * gain.astype(jnp.float32)


def flip_seq(a):
    return jnp.flip(a, axis=1)


def axial_rope_tables(seq_len, head_dim):
    rows = seq_len // GRID_W
    row_idx = jnp.repeat(jnp.arange(rows, dtype=jnp.float32), GRID_W)
    col_idx = jnp.tile(jnp.arange(GRID_W, dtype=jnp.float32), rows)
    axis_dim = head_dim // 2
    inv_freq = ROPE_THETA ** (-jnp.arange(0, axis_dim, 2, dtype=jnp.float32) / axis_dim)
    ang = jnp.concatenate([row_idx[:, None] * inv_freq, col_idx[:, None] * inv_freq], axis=-1)
    return jnp.cos(ang), jnp.sin(ang)


def apply_rope(x, cos, sin):
    half = x.shape[-1] // 2
    x1, x2 = x[..., :half], x[..., half:]
    c = cos[None, :, None, :]
    s = sin[None, :, None, :]
    return jnp.concatenate([x1 * c - x2 * s, x2 * c + x1 * s], axis=-1)


def bidirectional_gqa(q, k, v):
    B, S, _, d = q.shape
    nblk = S // QUERY_BLOCK
    qb = q.reshape(B, nblk, QUERY_BLOCK, ATTN_KV_HEADS, ATTN_GROUP, d).transpose(1, 0, 2, 3, 4, 5) * (d ** -0.5)

    def block(q_blk):
        s = jnp.einsum('bqhgd,bkhd->bhgqk', q_blk, k)
        p = jax.nn.softmax(s, axis=-1)
        return jnp.einsum('bhgqk,bkhd->bqhgd', p, v)

    o = lax.map(block, qb)
    return o.transpose(1, 0, 2, 3, 4, 5).reshape(B, S, ATTN_Q_WIDTH)


def mlstm_causal(q, k, v, log_i, log_f):
    B, S, H, dk = q.shape
    dv = v.shape[-1]
    L = MLSTM_CHUNK
    n_chunks = S // L

    def chunks(a):
        return jnp.moveaxis(a.reshape((B, n_chunks, L) + a.shape[2:]), 1, 0)

    mask = jnp.tril(jnp.ones((L, L), dtype=bool))

    def step(carry, xs):
        C, nv, m = carry
        qc, kc, vc, ic, fc = xs
        b = jnp.cumsum(fc, axis=1).transpose(0, 2, 1)
        ig = ic.transpose(0, 2, 1)
        dlog = jnp.where(mask, b[..., :, None] - b[..., None, :] + ig[..., None, :], -jnp.inf)
        inter = b + m[..., None]
        m_row = jnp.maximum(inter, jnp.max(dlog, axis=-1))
        w = jnp.exp(dlog - m_row[..., None]) * jnp.einsum('blhd,bkhd->bhlk', qc, kc)
        inter_w = jnp.exp(inter - m_row)
        num = (jnp.einsum('bhlk,bkhe->blhe', w, vc)
               + inter_w.transpose(0, 2, 1)[..., None] * jnp.einsum('blhd,bhde->blhe', qc, C))
        den = jnp.sum(w, axis=-1) + inter_w * jnp.einsum('blhd,bhd->bhl', qc, nv)
        h = num / jnp.maximum(jnp.abs(den), jnp.exp(-m_row)).transpose(0, 2, 1)[..., None]
        b_last = b[..., -1]
        wlog = b_last[..., None] - b + ig
        m_new = jnp.maximum(b_last + m, jnp.max(wlog, axis=-1))
        keep = jnp.exp(b_last + m - m_new)
        wk = jnp.exp(wlog - m_new[..., None])
        C_new = keep[..., None, None] * C + jnp.einsum('bhl,blhd,blhe->bhde', wk, kc, vc)
        n_new = keep[..., None] * nv + jnp.einsum('bhl,blhd->bhd', wk, kc)
        return (C_new, n_new, m_new), h

    init = (jnp.zeros((B, H, dk, dv), jnp.float32),
            jnp.zeros((B, H, dk), jnp.float32),
            jnp.zeros((B, H), jnp.float32))
    _, hs = lax.scan(step, init, (chunks(q), chunks(k), chunks(v), chunks(log_i), chunks(log_f)))
    return jnp.moveaxis(hs, 0, 1).reshape(B, S, H, dv)


def retention_causal(q, k, v, log_gamma, strict):
    B, S, H, dk = q.shape
    dv = v.shape[-1]
    L = RET_CHUNK
    n_chunks = S // L
    pos = jnp.arange(L, dtype=jnp.float32)
    diff = pos[:, None] - pos[None, :]
    mask = (diff > 0) if strict else (diff >= 0)
    intra_decay = jnp.where(mask[None], jnp.exp(jnp.maximum(diff, 0.0)[None] * log_gamma[:, None, None]), 0.0)
    query_decay = jnp.exp((pos + 1.0)[None, :] * log_gamma[:, None]).T
    key_decay = jnp.exp((L - 1.0 - pos)[None, :] * log_gamma[:, None])
    chunk_decay = jnp.exp(L * log_gamma)

    def chunks(a):
        return jnp.moveaxis(a.reshape((B, n_chunks, L) + a.shape[2:]), 1, 0)

    def step(state, xs):
        qc, kc, vc = xs
        scores = jnp.einsum('blhd,bkhd->bhlk', qc, kc) * intra_decay
        out = (jnp.einsum('bhlk,bkhe->blhe', scores, vc)
               + jnp.einsum('blhd,bhde->blhe', qc, state) * query_decay[None, :, :, None])
        state_new = chunk_decay[None, :, None, None] * state + jnp.einsum('hl,blhd,blhe->bhde', key_decay, kc, vc)
        return state_new, out

    init = jnp.zeros((B, H, dk, dv), jnp.float32)
    _, outs = lax.scan(step, init, (chunks(q), chunks(k), chunks(v)))
    return jnp.moveaxis(outs, 0, 1).reshape(B, S, H, dv)


def attn_mlstm_mixer(h, w_in, gate_bias, q_norm, k_norm, out_norm, w_out, cos_a, sin_a):
    B, S, _ = h.shape
    f32 = jnp.float32
    aq, ak, av, mq, mk, mv, mo, gates = jnp.split(h @ w_in, AB_SPLIT_POINTS, axis=-1)
    aq = apply_rope(head_rms_norm(aq.reshape(B, S, ATTN_HEADS, ATTN_HEAD_DIM), q_norm), cos_a, sin_a)
    ak = apply_rope(head_rms_norm(ak.reshape(B, S, ATTN_KV_HEADS, ATTN_HEAD_DIM), k_norm), cos_a, sin_a)
    av = av.reshape(B, S, ATTN_KV_HEADS, ATTN_HEAD_DIM).astype(f32)
    attn_out = bidirectional_gqa(aq, ak, av)
    mq = mq.reshape(B, S, MLSTM_HEADS, MLSTM_HEAD_DIM).astype(f32)
    mk = mk.reshape(B, S, MLSTM_HEADS, MLSTM_HEAD_DIM).astype(f32) * (MLSTM_HEAD_DIM ** -0.5)
    mv = mv.reshape(B, S, MLSTM_HEADS, MLSTM_HEAD_DIM).astype(f32)
    g = (gates.astype(f32) + gate_bias.astype(f32)).reshape(B, S, 4, MLSTM_HEADS)
    i_fwd, f_fwd = g[:, :, 0], jax.nn.log_sigmoid(g[:, :, 1])
    i_bwd, f_bwd = g[:, :, 2], jax.nn.log_sigmoid(g[:, :, 3])
    h_fwd = mlstm_causal(mq, mk, mv, i_fwd, f_fwd)
    h_bwd = flip_seq(mlstm_causal(flip_seq(mq), flip_seq(mk), flip_seq(mv), flip_seq(i_bwd), flip_seq(f_bwd)))
    m_out = head_rms_norm(h_fwd + h_bwd, out_norm.reshape(MLSTM_HEADS, MLSTM_HEAD_DIM)).reshape(B, S, MLSTM_WIDTH)
    m_out = m_out * jax.nn.sigmoid(mo.astype(f32))
    mixed = jnp.concatenate([attn_out, m_out], axis=-1).astype(h.dtype)
    return mixed @ w_out


def retention_mixer(h, w_in, decay_logit, out_norm, w_out, cos_r, sin_r):
    B, S, _ = h.shape
    f32 = jnp.float32
    rq, rk, rv, rg = jnp.split(h @ w_in, RET_SPLIT_POINTS, axis=-1)
    rq = apply_rope(rq.reshape(B, S, RET_HEADS, RET_QK_DIM).astype(f32), cos_r, sin_r)
    rk = apply_rope(rk.reshape(B, S, RET_HEADS, RET_QK_DIM).astype(f32), cos_r, sin_r) * (RET_QK_DIM ** -0.5)
    rv = rv.reshape(B, S, RET_HEADS, RET_V_DIM).astype(f32)
    log_gamma = jax.nn.log_sigmoid(decay_logit.astype(f32))
    y = (retention_causal(rq, rk, rv, log_gamma[0], False)
         + flip_seq(retention_causal(flip_seq(rq), flip_seq(rk), flip_seq(rv), log_gamma[1], True)))
    y = head_rms_norm(y, out_norm.reshape(RET_HEADS, RET_V_DIM)).reshape(B, S, RET_V_WIDTH)
    y = y * jax.nn.silu(rg.astype(f32))
    return y.astype(h.dtype) @ w_out


def conv_ffn(h, w_up, conv_w, conv_b, w_down):
    u, g = jnp.split(h @ w_up, 2, axis=-1)
    gp = jnp.pad(g, ((0, 0), (1, 1), (0, 0)))
    g = gp[:, :-2] * conv_w[0] + gp[:, 1:-1] * conv_w[1] + gp[:, 2:] * conv_w[2] + conv_b
    return (jax.nn.gelu(g, approximate=False) * u) @ w_down


def trunk(x, norm_mix, norm_ffn, norm_final, ab_w_in, ab_gate_bias, attn_q_norm, attn_k_norm,
          mlstm_out_norm, ab_w_out, ret_w_in, ret_decay_logit, ret_out_norm, ret_w_out,
          ffn_w_up, ffn_conv_w, ffn_conv_b, ffn_w_down):
    S = x.shape[1]
    cos_a, sin_a = axial_rope_tables(S, ATTN_HEAD_DIM)
    cos_r, sin_r = axial_rope_tables(S, RET_QK_DIM)
    for layer in range(DEPTH):
        j = layer // 2
        h = rms_norm(x, norm_mix[layer])
        if layer % 2 == 0:
            x = x + attn_mlstm_mixer(h, ab_w_in[j], ab_gate_bias[j], attn_q_norm[j], attn_k_norm[j],
                                     mlstm_out_norm[j], ab_w_out[j], cos_a, sin_a)
        else:
            x = x + retention_mixer(h, ret_w_in[j], ret_decay_logit[j], ret_out_norm[j], ret_w_out[j],
                                    cos_r, sin_r)
        x = x + conv_ffn(rms_norm(x, norm_ffn[layer]), ffn_w_up[layer], ffn_conv_w[layer],
                         ffn_conv_b[layer], ffn_w_down[layer])
    return rms_norm(x, norm_final)


def setup_inputs(seed: int = 0) -> dict:
    key = jax.random.key(seed)
    ks = jax.random.split(key, 20)
    nrm = jax.random.normal
    out_scale = (2.0 * DEPTH) ** -0.5
    f_bias = jnp.linspace(3.0, 6.0, MLSTM_HEADS, dtype=jnp.float32)
    zeros_h = jnp.zeros((MLSTM_HEADS,), jnp.float32)
    gate_base = jnp.concatenate([zeros_h, f_bias, zeros_h, f_bias])
    a = 5.0 + jnp.arange(RET_HEADS, dtype=jnp.float32)
    decay_base = jnp.log(2.0 ** a - 1.0)
    return {
        'x_prompt': nrm(ks[0], (BATCH, SEQ, D_MODEL), jnp.float32),
        'x_sample': nrm(ks[1], (DEC_BATCH, DEC_SEQ, D_MODEL), jnp.float32),
        'norm_mix': 1.0 + 0.05 * nrm(ks[2], (DEPTH, D_MODEL), jnp.float32),
        'norm_ffn': 1.0 + 0.05 * nrm(ks[3], (DEPTH, D_MODEL), jnp.float32),
        'norm_final': 1.0 + 0.05 * nrm(ks[4], (D_MODEL,), jnp.float32),
        'ab_w_in': nrm(ks[5], (N_AB_LAYERS, D_MODEL, AB_IN_COLS), jnp.float32) * D_MODEL ** -0.5,
        'ab_gate_bias': gate_base + 0.1 * nrm(ks[6], (N_AB_LAYERS, MLSTM_GATES), jnp.float32),
        'attn_q_norm': 1.0 + 0.05 * nrm(ks[7], (N_AB_LAYERS, ATTN_HEAD_DIM), jnp.float32),
        'attn_k_norm': 1.0 + 0.05 * nrm(ks[8], (N_AB_LAYERS, ATTN_HEAD_DIM), jnp.float32),
        'mlstm_out_norm': 1.0 + 0.05 * nrm(ks[9], (N_AB_LAYERS, MLSTM_WIDTH), jnp.float32),
        'ab_w_out': nrm(ks[10], (N_AB_LAYERS, AB_MIX_WIDTH, D_MODEL), jnp.float32) * AB_MIX_WIDTH ** -0.5 * out_scale,
        'ret_w_in': nrm(ks[11], (N_RET_LAYERS, D_MODEL, RET_IN_COLS), jnp.float32) * D_MODEL ** -0.5,
        'ret_decay_logit': decay_base + 0.05 * nrm(ks[12], (N_RET_LAYERS, 2, RET_HEADS), jnp.float32),
        'ret_out_norm': 1.0 + 0.05 * nrm(ks[13], (N_RET_LAYERS, RET_V_WIDTH), jnp.float32),
        'ret_w_out': nrm(ks[14], (N_RET_LAYERS, RET_V_WIDTH, D_MODEL), jnp.float32) * RET_V_WIDTH ** -0.5 * out_scale,
        'ffn_w_up': nrm(ks[15], (DEPTH, D_MODEL, 2 * D_FF), jnp.float32) * D_MODEL ** -0.5,
        'ffn_conv_w': nrm(ks[16], (DEPTH, CONV_WIDTH, D_FF), jnp.float32) * CONV_WIDTH ** -0.5,
        'ffn_conv_b': 0.02 * nrm(ks[17], (DEPTH, D_FF), jnp.float32),
        'ffn_w_down': nrm(ks[18], (DEPTH, D_FF, D_MODEL), jnp.float32) * D_FF ** -0.5 * out_scale,
    }


def reference(x_prompt, x_sample, norm_mix, norm_ffn, norm_final, ab_w_in, ab_gate_bias, attn_q_norm,
              attn_k_norm, mlstm_out_norm, ab_w_out, ret_w_in, ret_decay_logit, ret_out_norm, ret_w_out,
              ffn_w_up, ffn_conv_w, ffn_conv_b, ffn_w_down):
    y_prompt = trunk(x_prompt, norm_mix, norm_ffn, norm_final, ab_w_in, ab_gate_bias, attn_q_norm,
                     attn_k_norm, mlstm_out_norm, ab_w_out, ret_w_in, ret_decay_logit, ret_out_norm,
                     ret_w_out, ffn_w_up, ffn_conv_w, ffn_conv_b, ffn_w_down)
    y_sample = trunk(x_sample, norm_mix, norm_ffn, norm_final, ab_w_in, ab_gate_bias, attn_q_norm,
                     attn_k_norm, mlstm_out_norm, ab_w_out, ret_w_in, ret_decay_logit, ret_out_norm,
                     ret_w_out, ffn_w_up, ffn_conv_w, ffn_conv_b, ffn_w_down)
    return (y_prompt, y_sample)
```

```cpp
#include <hip/hip_runtime.h>
#include <hip/hip_cooperative_groups.h>
#include <cstdio>
#include <cstdint>
namespace cg = cooperative_groups;
#ifndef PROBE_MASK
#define PROBE_MASK 0
#endif
#ifndef PROBE_VAR
#define PROBE_VAR 0
#endif
namespace pg8 {
#define PG8_LAS __attribute__((address_space(3)))
typedef unsigned short bf16_t;
typedef short bf16x8 __attribute__((ext_vector_type(8)));
typedef float f32x4 __attribute__((ext_vector_type(4)));
typedef unsigned u32x4 __attribute__((ext_vector_type(4)));
constexpr int BM = 256, BK = 64, HALF = 128, HTB = HALF * BK * 2  , STAGE_BYTES = 8 * HTB, NXCD = 8, WGM = 2;

__host__ __device__ __forceinline__ int lds_byte(int r, int c) { const int st = (r >> 4) * 2 + (c >> 5), rr = r & 15, cc = c & 31, ob = rr * 64 + cc * 2; return st * 1024 + (ob ^ (((ob >> 9) & 1) << 5)); }
__host__ __device__ __forceinline__ void stage_rc(int b, int& R, int& C) { const int st = b / 1024, sb = b % 1024, swz = sb ^ (((sb >> 9) & 1) << 5); R = (st >> 1) * 16 + swz / 64; C = (st & 1) * 32 + (swz % 64) / 2; }
__host__ __device__ __forceinline__ int perm32(int rho) { const int n = rho >> 4, i = rho & 15; return 8 * (i >> 2) + 4 * n + (i & 3); }

struct Unit { int pm, pn; };
struct Gemm { const bf16_t* A; const bf16_t* Bt; int M, N, K; };

struct StaticOrder {
    int nM, nN, nwg, G, c;
    __host__ __device__ void init(int M, int N, int G_, int c_) { nM = M / BM; nN = N / BM; nwg = nM * nN; G = G_; c = c_; }
    __host__ __device__ bool next(int i, Unit& u) const {
        const long L = (long)i * G + c; if (L >= nwg) return false;
        int wgid = (int)L; { const int q = nwg / NXCD, r = nwg % NXCD, xcd = wgid % NXCD, off = wgid / NXCD; wgid = (xcd < r ? xcd * (q + 1) : r * (q + 1) + (xcd - r) * q) + off; }
        const int nig = WGM * nN, gid = wgid / nig, fm = gid * WGM, gsz = (nM - fm) < WGM ? (nM - fm) : WGM;
        u.pm = fm + ((wgid % nig) % gsz); u.pn = (wgid % nig) / gsz; return true;
    }
    __device__ __forceinline__ void a_ready(const Unit&) const {}
    __device__ __forceinline__ void done(const Unit&) const {}
};

template <class Epi, class Sched, bool ALIGN_EPI = false, bool SP2 = false>
__device__ __forceinline__ void gemm_phase(PG8_LAS unsigned char* lds, const Gemm g, const Sched& S, const Epi& E) {
    int tid_o = threadIdx.x; asm volatile("" : "+v"(tid_o)); const int tid = tid_o, wid = __builtin_amdgcn_readfirstlane(tid >> 6), lane = tid & 63, wr = wid >> 2, wc = wid & 3, fr = lane & 15, fq = lane >> 4;
    const int K = g.K, nt = K / BK;
    unsigned voffA[2], voffB[2];
#pragma unroll
    for (int i = 0; i < 2; ++i) { int R, C; stage_rc(tid * 16 + i * 8192, R, C); const int Rb = Epi::PERM ? ((R & ~31) + perm32(R & 31)) : R;
        voffA[i] = (unsigned)(R * K + C) * 2u; voffB[i] = (unsigned)(Rb * K + C) * 2u; }
    const size_t kstep = (size_t)(BK * 2);
    const size_t hstep = (size_t)HALF * K * 2;
    const size_t tstep = 2 * hstep;
    const unsigned ldsw = (unsigned)wid * 1024u;
    const int aoff = lds_byte(wr * 64 + fr, fq * 8), boff = lds_byte(wc * 32 + fr, fq * 8);
#define PG8_SA(b, h) (((b) * 2 + (h)) * HTB)
#define PG8_SB(b, h) ((4 + (b) * 2 + (h)) * HTB)
#define PG8_STAGE(bufoff, gbase, voff) do { _Pragma("unroll") for (int _i = 0; _i < 2; ++_i) \
        __builtin_amdgcn_global_load_lds((const unsigned*)((const char*)(gbase) + (voff)[_i]), (PG8_LAS unsigned*)(lds + (bufoff) + ldsw + _i * 8192), 16, 0, 0); } while (0)
#define PG8_LDA(dst, b, h) do { _Pragma("unroll") for (int m = 0; m < 4; ++m) _Pragma("unroll") for (int k = 0; k < 2; ++k) dst[m][k] = *(const PG8_LAS bf16x8*)(lds + PG8_SA(b, h) + aoff + m * 2048 + k * 1024); } while (0)
#define PG8_LDB(dst, b, h) do { _Pragma("unroll") for (int n = 0; n < 2; ++n) _Pragma("unroll") for (int k = 0; k < 2; ++k) dst[n][k] = *(const PG8_LAS bf16x8*)(lds + PG8_SB(b, h) + boff + n * 2048 + k * 1024); } while (0)
#define PG8_MMA(ai, bj, At, Bt) do { __builtin_amdgcn_s_setprio(1); _Pragma("unroll") for (int m = 0; m < 4; ++m) _Pragma("unroll") for (int n = 0; n < 2; ++n) _Pragma("unroll") for (int k = 0; k < 2; ++k) \
        acc[ai][bj][m][n] = __builtin_amdgcn_mfma_f32_16x16x32_bf16(Bt[n][k], At[m][k], acc[ai][bj][m][n], 0, 0, 0); __builtin_amdgcn_s_setprio(0); } while (0)
#define PG8_WAIT_V(n) asm volatile("s_waitcnt vmcnt(" #n ")" ::: "memory")
#define PG8_WAIT_L(n) asm volatile("s_waitcnt lgkmcnt(" #n ")" ::: "memory")
#define PG8_BAR __builtin_amdgcn_s_barrier()
#define PG8_SCHED __builtin_amdgcn_sched_barrier(0)
    Unit cur, nxt; int ui = 0;
    if (!S.next(0, cur)) return;
    f32x4 acc[2][2][4][2];
    E.init(acc, cur, wr, wc, fr, fq);
    bf16x8 At[4][2], B0[2][2], B1[2][2];
    const char* cA = (const char*)g.A + (size_t)cur.pm * tstep; const char* cB = (const char*)g.Bt + (size_t)cur.pn * tstep;
    S.a_ready(cur);
    if constexpr (SP2) {
        PG8_STAGE(PG8_SB(0, 0), cB, voffB); PG8_STAGE(PG8_SB(0, 1), cB + hstep, voffB); PG8_STAGE(PG8_SA(0, 0), cA, voffA); PG8_STAGE(PG8_SA(0, 1), cA + hstep, voffA);
        if (wr == 1) PG8_BAR;
        PG8_WAIT_V(2); PG8_BAR;
        PG8_STAGE(PG8_SB(1, 0), cB + kstep, voffB); PG8_STAGE(PG8_SA(1, 0), cA + kstep, voffA); PG8_STAGE(PG8_SB(1, 1), cB + hstep + kstep, voffB);
        PG8_WAIT_V(6); PG8_BAR;
    } else {
        PG8_STAGE(PG8_SB(0, 0), cB, voffB); PG8_STAGE(PG8_SA(0, 0), cA, voffA); PG8_STAGE(PG8_SB(0, 1), cB + hstep, voffB); PG8_STAGE(PG8_SA(0, 1), cA + hstep, voffA);
        if (wr == 1) PG8_BAR;
        PG8_WAIT_V(4); PG8_BAR;
        PG8_STAGE(PG8_SB(1, 0), cB + kstep, voffB); PG8_STAGE(PG8_SA(1, 0), cA + kstep, voffA); PG8_STAGE(PG8_SB(1, 1), cB + hstep + kstep, voffB);
        PG8_WAIT_V(6); PG8_BAR;
    }
    for (;;) {
        const bool has_next = S.next(ui + 1, nxt);
        const char* nA = has_next ? (const char*)g.A + (size_t)nxt.pm * tstep : cA; const char* nB = has_next ? (const char*)g.Bt + (size_t)nxt.pn * tstep : cB;
        for (int t = 0; t < nt; t += 2) {
            const bool last = (t == nt - 2);
            const char* a1 = cA + (size_t)(t + 1) * kstep;
            const char* a2 = last ? nA : cA + (size_t)(t + 2) * kstep; const char* b2 = last ? nB : cB + (size_t)(t + 2) * kstep;
            const char* a3 = a2 + kstep; const char* b3 = b2 + kstep;
            if (last && has_next) S.a_ready(nxt);
            if constexpr (SP2) {
            PG8_LDB(B0, 0, 0); PG8_LDB(B1, 0, 1); PG8_SCHED; PG8_LDA(At, 0, 0); PG8_STAGE(PG8_SA(1, 1), a1 + hstep, voffA);
            PG8_WAIT_V(8); PG8_WAIT_L(0); PG8_BAR; PG8_MMA(0, 0, At, B0); PG8_MMA(0, 1, At, B1); PG8_BAR; PG8_SCHED;
            PG8_LDA(At, 0, 1); PG8_STAGE(PG8_SB(0, 0), b2, voffB); PG8_STAGE(PG8_SB(0, 1), b2 + hstep, voffB); PG8_STAGE(PG8_SA(0, 0), a2, voffA);
            PG8_WAIT_V(8); PG8_WAIT_L(0); PG8_BAR; PG8_MMA(1, 0, At, B0); PG8_MMA(1, 1, At, B1); PG8_BAR; PG8_SCHED;
            PG8_LDB(B0, 1, 0); PG8_LDB(B1, 1, 1); PG8_SCHED; PG8_LDA(At, 1, 0); PG8_STAGE(PG8_SA(0, 1), a2 + hstep, voffA);
            PG8_WAIT_V(8); PG8_WAIT_L(0); PG8_BAR; PG8_MMA(0, 0, At, B0); PG8_MMA(0, 1, At, B1); PG8_BAR; PG8_SCHED;
            PG8_LDA(At, 1, 1); PG8_STAGE(PG8_SB(1, 0), b3, voffB); PG8_STAGE(PG8_SB(1, 1), b3 + hstep, voffB); PG8_STAGE(PG8_SA(1, 0), a3, voffA);
            PG8_WAIT_V(8); PG8_WAIT_L(0); PG8_BAR; PG8_MMA(1, 0, At, B0); PG8_MMA(1, 1, At, B1); PG8_BAR; PG8_SCHED;
            } else {
            PG8_LDB(B0, 0, 0); PG8_SCHED; PG8_LDA(At, 0, 0); PG8_STAGE(PG8_SA(1, 1), a1 + hstep, voffA);
            PG8_WAIT_L(8); PG8_BAR; PG8_WAIT_L(0); PG8_MMA(0, 0, At, B0); PG8_BAR; PG8_SCHED;
            PG8_LDB(B1, 0, 1); PG8_STAGE(PG8_SB(0, 0), b2, voffB);
            PG8_BAR; PG8_WAIT_L(0); PG8_MMA(0, 1, At, B1); PG8_BAR;
            PG8_LDA(At, 0, 1); PG8_STAGE(PG8_SA(0, 0), a2, voffA);
            PG8_BAR; PG8_WAIT_L(0); PG8_MMA(1, 0, At, B0); PG8_BAR; PG8_SCHED;
            PG8_STAGE(PG8_SB(0, 1), b2 + hstep, voffB);
            PG8_WAIT_V(6); PG8_BAR; PG8_MMA(1, 1, At, B1); PG8_BAR;
            PG8_LDB(B0, 1, 0); PG8_SCHED; PG8_LDA(At, 1, 0); PG8_STAGE(PG8_SA(0, 1), a2 + hstep, voffA);
            PG8_WAIT_L(8); PG8_BAR; PG8_WAIT_L(0); PG8_MMA(0, 0, At, B0); PG8_BAR; PG8_SCHED;
            PG8_LDB(B1, 1, 1); PG8_STAGE(PG8_SB(1, 0), b3, voffB);
            PG8_BAR; PG8_WAIT_L(0); PG8_MMA(0, 1, At, B1); PG8_BAR;
            PG8_LDA(At, 1, 1); PG8_STAGE(PG8_SA(1, 0), a3, voffA);
            PG8_BAR; PG8_WAIT_L(0); PG8_MMA(1, 0, At, B0); PG8_BAR; PG8_SCHED;
            PG8_STAGE(PG8_SB(1, 1), b3 + hstep, voffB);
            PG8_WAIT_V(6); PG8_BAR; PG8_MMA(1, 1, At, B1); PG8_BAR;
            }
        }
        if constexpr (ALIGN_EPI) { if (wr == 0) PG8_BAR; }
        if constexpr (!Epi::AFTER_DRAIN) { E(acc, cur, wr, wc, fr, fq); S.done(cur); }
        if (!has_next) break;
        E.init(acc, nxt, wr, wc, fr, fq);
        cur = nxt; cA = nA; cB = nB; ++ui;
        if constexpr (ALIGN_EPI) { if (wr == 1) PG8_BAR; }
    }
    PG8_WAIT_V(0);
    if constexpr (!ALIGN_EPI) { if (wr == 0) PG8_BAR; }
    PG8_BAR;
    if constexpr (Epi::AFTER_DRAIN) { E.fused(acc, cur, wr, wc, fr, fq, lds, wid, lane); S.done(cur); }
#undef PG8_SA
#undef PG8_SB
#undef PG8_STAGE
#undef PG8_LDA
#undef PG8_LDB
#undef PG8_MMA
#undef PG8_WAIT_V
#undef PG8_WAIT_L
#undef PG8_BAR
#undef PG8_SCHED
}
}
#define LAS __attribute__((address_space(3)))
typedef unsigned short bf16_t;
typedef short bf16x8 __attribute__((ext_vector_type(8)));
typedef short s16x4 __attribute__((ext_vector_type(4)));
typedef float f32x4 __attribute__((ext_vector_type(4)));
typedef float f32x16 __attribute__((ext_vector_type(16)));
typedef unsigned u32x4 __attribute__((ext_vector_type(4)));
typedef unsigned u32x2 __attribute__((ext_vector_type(2)));
typedef float f32x2_t __attribute__((ext_vector_type(2)));
typedef __bf16 bf16x2_t __attribute__((ext_vector_type(2)));

constexpr int NTHREADS = 512;
constexpr int LDS_BYTES = 147456;
constexpr int DM = 1024;
constexpr int CH_ROWS = 16384;
constexpr int TOT_ROWS = 49152;
constexpr float EPS = 1e-6f;
constexpr float LOG2E = 1.4426950408889634f;

constexpr size_t MiB = 1u << 20;
constexpr size_t W_ABIN = 0, W_ABIN_SZ = (size_t)3072 * 1024 * 2;
constexpr size_t W_ABOUT = W_ABIN + 2 * W_ABIN_SZ, W_ABOUT_SZ = (size_t)1024 * 1024 * 2;
constexpr size_t W_RETIN = W_ABOUT + 2 * W_ABOUT_SZ, W_RETIN_SZ = (size_t)6144 * 1024 * 2;
constexpr size_t W_RETOUT = W_RETIN + 2 * W_RETIN_SZ, W_RETOUT_SZ = (size_t)1024 * 2048 * 2;
constexpr size_t W_UP = W_RETOUT + 2 * W_RETOUT_SZ, W_UP_SZ = (size_t)5632 * 1024 * 2;
constexpr size_t W_DOWN = W_UP + 4 * W_UP_SZ, W_DOWN_SZ = (size_t)1024 * 2816 * 2;
static_assert(W_DOWN + 4 * W_DOWN_SZ <= 120 * MiB, "weights");
constexpr size_t WS_XB = 120 * MiB;
constexpr size_t WS_BIG1 = 152 * MiB;
constexpr size_t WS_BIG2 = 344 * MiB;
constexpr size_t WS_SSQ = 472 * MiB;
constexpr size_t WS_GATES = 475 * MiB;
constexpr size_t WS_ROPE = 476 * MiB;
constexpr size_t WS_END = 486 * MiB;
constexpr int RA_ROW = 0, RA_COL = 128 * 16, RR_ROW = RA_COL + 64 * 16, RR_COL = RR_ROW + 128 * 64, ROPE_N = RR_COL + 64 * 64;
constexpr size_t WS_CTL = 486 * MiB, CTL_BYTES = 65536;

struct Params { const float* in[19]; float* out; unsigned char* ws; };

__device__ __forceinline__ unsigned cvtpk(float lo, float hi) { f32x2_t v = {lo, hi}; bf16x2_t b = __builtin_convertvector(v, bf16x2_t); return __builtin_bit_cast(unsigned, b); }
__device__ __forceinline__ bf16_t f2bf(float f) { return (bf16_t)(cvtpk(f, 0.f) & 0xffffu); }
__device__ __forceinline__ float bf2f(bf16_t b) { return __uint_as_float((unsigned)b << 16); }
__device__ __forceinline__ float bflo(unsigned u) { return __uint_as_float(u << 16); }
__device__ __forceinline__ float bfhi(unsigned u) { return __uint_as_float(u & 0xffff0000u); }
__device__ __forceinline__ float wave_sum(float v) {
#pragma unroll
    for (int o = 1; o < 64; o <<= 1) v += __shfl_xor(v, o);
    return v;
}
__device__ __forceinline__ float sigmoidf_(float x) { return 1.f / (1.f + __expf(-x)); }
__device__ __forceinline__ float logsigmoidf_(float x) { return fminf(x, 0.f) - log1pf(__expf(-fabsf(x))); }

__device__ __forceinline__ bf16x8 lds_rows(const LAS bf16_t* base, int ld, int row0, int k0, int lane) {
    return *(const LAS bf16x8*)(base + (row0 + (lane & 31)) * ld + k0 + 8 * (lane >> 5));
}
__device__ __forceinline__ s16x4 tr16(const LAS bf16_t* p) {
    return __builtin_bit_cast(s16x4, __builtin_amdgcn_ds_read_tr16_b64_v4i16((LAS s16x4*)p));
}
__device__ __forceinline__ bf16x8 lds_tr(const LAS bf16_t* base, int ld, int k0, int c0, int lane) {
#ifdef SLOW_TR
    bf16x8 o;
#pragma unroll
    for (int j = 0; j < 8; ++j) o[j] = (short)base[(k0 + 8 * (lane >> 5) + j) * ld + c0 + (lane & 31)];
    return o;
#else
    const int g = lane >> 4, i = lane & 15, q = i >> 2, p = i & 3, h = g >> 1;
    const LAS bf16_t* a = base + (k0 + 8 * h + q) * ld + c0 + 16 * (g & 1) + 4 * p;
    const s16x4 lo = tr16(a), hi = tr16(a + 4 * ld);
    return (bf16x8){lo[0], lo[1], lo[2], lo[3], hi[0], hi[1], hi[2], hi[3]};
#endif
}
__device__ __forceinline__ bf16x8 lds_tr_perm(const LAS bf16_t* base, int ld, int k0, int c0, int lane) {
#ifdef SLOW_TR
    bf16x8 o;
#pragma unroll
    for (int j = 0; j < 8; ++j) o[j] = (short)base[(k0 + 8 * (j >> 2) + 4 * (lane >> 5) + (j & 3)) * ld + c0 + (lane & 31)];
    return o;
#else
    const int g = lane >> 4, i = lane & 15, q = i >> 2, p = i & 3, h = g >> 1;
    const LAS bf16_t* a = base + (k0 + 4 * h + q) * ld + c0 + 16 * (g & 1) + 4 * p;
    const s16x4 lo = tr16(a), hi = tr16(a + 8 * ld);
    return (bf16x8){lo[0], lo[1], lo[2], lo[3], hi[0], hi[1], hi[2], hi[3]};
#endif
}
__device__ __forceinline__ f32x16 mfma32(bf16x8 a, bf16x8 b, f32x16 c) { return __builtin_amdgcn_mfma_f32_32x32x16_bf16(a, b, c, 0, 0, 0); }
__device__ __forceinline__ bf16x8 pack8(const f32x16& a, int s) {
    u32x4 w; w.x = cvtpk(a[8 * s + 0], a[8 * s + 1]); w.y = cvtpk(a[8 * s + 2], a[8 * s + 3]); w.z = cvtpk(a[8 * s + 4], a[8 * s + 5]); w.w = cvtpk(a[8 * s + 6], a[8 * s + 7]);
    return __builtin_bit_cast(bf16x8, w);
}
__device__ __forceinline__ int accrow(int reg, int h) { return (reg & 3) + 8 * (reg >> 2) + 4 * h; }
__device__ __forceinline__ float gelu_as(float v) {
    const float av = fabsf(v), t = __builtin_amdgcn_rcpf(av * 0.2316418882f + 1.0f);
    float q = t * 0.5307027145f + (-0.7265760135f); q = q * t + 0.7107068705f; q = q * t + (-0.142248368f); q = q * t + 0.127414796f; q = q * t;
    const float e = __builtin_amdgcn_exp2f((v * v) * (-0.72134752044f));
    const float m = v * (q * e);
    return v < 0.f ? m : v - m;
}
#define XB_TMO      128
#define XB_XCNT(j)  (256  + 64 * (j))
#define XB_XSUB(j)  (1280 + 64 * (j))
#define XB_XGEN(j)  (2304 + 64 * (j))
#define XB_TOP      3328
#define XB_TOPGEN   3392
#define XCD_BAR_WORDS 3456
#define XB_SPIN_CAP (1u << 18)

__device__ __forceinline__ unsigned xb_ld(unsigned* p)              { return __hip_atomic_load(p, __ATOMIC_RELAXED, __HIP_MEMORY_SCOPE_AGENT); }
__device__ __forceinline__ unsigned xb_add(unsigned* p, unsigned v) { return __hip_atomic_fetch_add(p, v, __ATOMIC_RELAXED, __HIP_MEMORY_SCOPE_AGENT); }
__device__ __forceinline__ unsigned xb_xcc_id() { return (unsigned)__builtin_amdgcn_s_getreg((3 << 11) | 20) & 0xFu; }
#define XB_SPIN(cond, bar) do { unsigned _sp = 0; while (cond) { __builtin_amdgcn_s_sleep(1); \
    if ((++_sp & 255u) == 0u) { if (xb_ld(&(bar)[XB_TMO])) break; if (_sp > XB_SPIN_CAP) { atomicAdd(&(bar)[XB_TMO], 1u); break; } } } } while (0)

struct XcdBarrier {
    unsigned* bar; unsigned x;
    volatile LAS unsigned* st;
};

__device__ __forceinline__ XcdBarrier xcd_barrier_post(unsigned* bar, volatile LAS unsigned* st) {
    XcdBarrier b; b.bar = bar; b.x = xb_xcc_id(); b.st = st;
    if (threadIdx.x == 0) (void)xb_add(&bar[XB_XCNT(b.x)], 1u);
    return b;
}
__device__ __forceinline__ void xcd_barrier_complete(unsigned* bar, unsigned x, unsigned& nloc, unsigned& nx) {
    const unsigned G = gridDim.x * gridDim.y * gridDim.z;
    unsigned sum, cnt, mine, sp = 0u;
    for (;;) {
        sum = 0u; cnt = 0u; mine = 0u;
#pragma unroll
        for (unsigned j = 0; j < 16; ++j) { const unsigned c = xb_ld(&bar[XB_XCNT(j)]); sum += c; cnt += (c > 0u) ? 1u : 0u; mine = (j == x) ? c : mine; }
        if (sum == G) break;
        __builtin_amdgcn_s_sleep(1);
        if ((++sp & 255u) == 0u) { if (xb_ld(&bar[XB_TMO])) break; if (sp > XB_SPIN_CAP) { atomicAdd(&bar[XB_TMO], 1u); break; } }
    }
    nloc = mine > 0u ? mine : 1u; nx = cnt > 0u ? cnt : 1u;
}

__device__ __forceinline__ void xcd_barrier(const XcdBarrier& b) {
    asm volatile("s_waitcnt vmcnt(0)" ::: "memory");
    __syncthreads();
    if (threadIdx.x == 0) {
        unsigned* bar = b.bar;
        __builtin_amdgcn_s_waitcnt(0);
        unsigned nloc = b.st[0], nx = b.st[1];
        if (nloc == 0u) { xcd_barrier_complete(bar, b.x, nloc, nx); b.st[0] = nloc; b.st[1] = nx; }
        const unsigned old = xb_add(&bar[XB_XSUB(b.x)], 1u);
        const unsigned gen = old / nloc;
        if (old + 1u == (gen + 1u) * nloc) {
            __builtin_amdgcn_fence(__ATOMIC_RELEASE, "agent");
            asm volatile("s_waitcnt vmcnt(0)" ::: "memory");
            const unsigned og = xb_add(&bar[XB_TOP], 1u);
            const unsigned tg = og / nx;
            if (og + 1u == (tg + 1u) * nx) xb_add(&bar[XB_TOPGEN], 1u);
            else XB_SPIN(xb_ld(&bar[XB_TOPGEN]) == tg, bar);
            __builtin_amdgcn_fence(__ATOMIC_ACQUIRE, "agent");
            xb_add(&bar[XB_XGEN(b.x)], 1u);
            asm volatile("s_waitcnt vmcnt(0)" ::: "memory");
        } else {
            XB_SPIN(xb_ld(&bar[XB_XGEN(b.x)]) == gen, bar);
            __builtin_amdgcn_fence(__ATOMIC_ACQUIRE, "agent");
            asm volatile("s_waitcnt vmcnt(0)" ::: "memory");
        }
    }
    __syncthreads();
}
struct EpiF {
    bf16_t* O; int ldo;
    const float* ssq;
    float* gates;
    bf16_t* qt; int colsub;
    bf16_t* act; bf16_t* sb; const float* cw; const float* cb;
    const float* qn; const float* kn; const float* cosa; const float* sina;
    const float* cosr; const float* sinr; int seqmask;
    float* x; bf16_t* xb; float* ssq_out;
};
template <int MODE  > struct EpiT : EpiF {
    static constexpr bool PERM = true, AFTER_DRAIN = false;
    static constexpr int mode = MODE;
    __device__ __forceinline__ void init(pg8::f32x4 (&acc)[2][2][4][2], const pg8::Unit& u, int wr, int wc, int fr, int fq) const {
        if (false) {
            const int rowb = u.pm * 256 + wr * 64 + fr, colb = u.pn * 256 + wc * 32 + 8 * fq;
#pragma unroll
            for (int ai = 0; ai < 2; ++ai)
#pragma unroll
                for (int m = 0; m < 4; ++m) {
                    const float* xr = x + (size_t)(rowb + ai * 128 + m * 16) * DM + colb;
#pragma unroll
                    for (int bj = 0; bj < 2; ++bj) { acc[ai][bj][m][0] = *(const f32x4*)(xr + bj * 128); acc[ai][bj][m][1] = *(const f32x4*)(xr + bj * 128 + 4); }
                }
        } else {
#pragma unroll
            for (int ai = 0; ai < 2; ++ai)
#pragma unroll
                for (int bj = 0; bj < 2; ++bj)
#pragma unroll
                    for (int m = 0; m < 4; ++m) { acc[ai][bj][m][0] = (f32x4){0.f, 0.f, 0.f, 0.f}; acc[ai][bj][m][1] = (f32x4){0.f, 0.f, 0.f, 0.f}; }
        }
    }
    __device__ __forceinline__ void operator()(const pg8::f32x4 (&acc)[2][2][4][2], const pg8::Unit& u, int wr, int wc, int fr, int fq) const {
        const int rowb = u.pm * 256 + wr * 64 + fr;
        const int colb = u.pn * 256 + wc * 32 + 8 * fq;
        if (mode == 3) {
#pragma unroll
            for (int ai = 0; ai < 2; ++ai)
#pragma unroll
                for (int m = 0; m < 4; ++m) {
                    const int row = rowb + ai * 128 + m * 16;
                    bf16_t* xbr = xb + (size_t)row * DM + colb;
                    float ss = 0.f;
#pragma unroll
                    for (int bj = 0; bj < 2; ++bj) {
                        const u32x4 xo = *(const u32x4*)(xbr + bj * 128);
                        f32x4 v0 = acc[ai][bj][m][0], v1 = acc[ai][bj][m][1];
                        v0[0] += bflo(xo.x); v0[1] += bfhi(xo.x); v0[2] += bflo(xo.y); v0[3] += bfhi(xo.y);
                        v1[0] += bflo(xo.z); v1[1] += bfhi(xo.z); v1[2] += bflo(xo.w); v1[3] += bfhi(xo.w);
                        if (x) {
                            float* xr = x + (size_t)row * DM + colb + bj * 128;
                            *(f32x4*)xr = v0; *(f32x4*)(xr + 4) = v1;
                        } else {
                            u32x4 w; w.x = cvtpk(v0[0], v0[1]); w.y = cvtpk(v0[2], v0[3]); w.z = cvtpk(v1[0], v1[1]); w.w = cvtpk(v1[2], v1[3]);
                            *(u32x4*)(xbr + bj * 128) = w;
                            v0[0] = bflo(w.x); v0[1] = bfhi(w.x); v0[2] = bflo(w.y); v0[3] = bfhi(w.y); v1[0] = bflo(w.z); v1[1] = bfhi(w.z); v1[2] = bflo(w.w); v1[3] = bfhi(w.w);
                        }
                        ss += (v0[0] * v0[0] + v0[1] * v0[1]) + (v0[2] * v0[2] + v0[3] * v0[3]) + (v1[0] * v1[0] + v1[1] * v1[1]) + (v1[2] * v1[2] + v1[3] * v1[3]);
                    }
                    ss += __shfl_xor(ss, 16); ss += __shfl_xor(ss, 32);
                    if (fq == 0) ssq_out[(size_t)row * 16 + u.pn * 4 + wc] = ss;
                }
            return;
        }
        if (mode == 2) {
            const int lane16 = fr;
            const int ch0 = u.pn * 128 + wc * 32 + 8 * fq;
            f32x4 kw0[2], kw1[2], kw2[2], kb[2];
#pragma unroll
            for (int n = 0; n < 2; ++n) { kw0[n] = *(const f32x4*)(cw + ch0 + 4 * n); kw1[n] = *(const f32x4*)(cw + 2816 + ch0 + 4 * n); kw2[n] = *(const f32x4*)(cw + 5632 + ch0 + 4 * n); kb[n] = *(const f32x4*)(cb + ch0 + 4 * n); }
            float rsa[2][4];
            {
                f32x4 sv[2][4];
#pragma unroll
                for (int ai = 0; ai < 2; ++ai)
#pragma unroll
                    for (int m = 0; m < 4; ++m) sv[ai][m] = *(const f32x4*)(ssq + (size_t)(rowb + ai * 128 + m * 16) * 16 + 4 * fq);
#pragma unroll
                for (int ai = 0; ai < 2; ++ai)
#pragma unroll
                    for (int m = 0; m < 4; ++m) {
                        float ss = (sv[ai][m][0] + sv[ai][m][1]) + (sv[ai][m][2] + sv[ai][m][3]);
                        ss += __shfl_xor(ss, 16); ss += __shfl_xor(ss, 32);
                        rsa[ai][m] = rsqrtf(ss * (1.0f / DM) + EPS);
                    }
            }
#pragma unroll
            for (int ai = 0; ai < 2; ++ai) {
                float rs[4];
#pragma unroll
                for (int m = 0; m < 4; ++m) rs[m] = rsa[ai][m];
#pragma unroll
                for (int m = 0; m < 4; ++m) {
                    const int row = rowb + ai * 128 + m * 16;
                    const int mp = (m > 0) ? m - 1 : 0, mn = (m < 3) ? m + 1 : 3;
                    u32x4 wo, wu, wg; unsigned wv[4], uvv[4], gvv[4];
#pragma unroll
                    for (int n = 0; n < 2; ++n) {
                        const f32x4 us = acc[ai][0][m][n] * rs[m];
                        float y[4];
#pragma unroll
                        for (int jj = 0; jj < 4; ++jj) {
                            const float gc = acc[ai][1][m][n][jj] * rs[m];
                            const float tp = (lane16 == 15) ? acc[ai][1][mp][n][jj] * rs[mp] : gc, tn = (lane16 == 0) ? acc[ai][1][mn][n][jj] * rs[mn] : gc;
                            const float gprev = __int_as_float(__builtin_amdgcn_update_dpp(0, __float_as_int(tp), 0x121, 0xf, 0xf, false));
                            const float gnext = __int_as_float(__builtin_amdgcn_update_dpp(0, __float_as_int(tn), 0x12f, 0xf, 0xf, false));
                            const float yy = gprev * kw0[n][jj] + gc * kw1[n][jj] + gnext * kw2[n][jj] + kb[n][jj];
                            y[jj] = gelu_as(yy) * us[jj];
                        }
                        wv[2 * n] = cvtpk(y[0], y[1]); wv[2 * n + 1] = cvtpk(y[2], y[3]);
                        uvv[2 * n] = cvtpk(us[0], us[1]); uvv[2 * n + 1] = cvtpk(us[2], us[3]);
                        { const f32x4 gq = acc[ai][1][m][n] * rs[m]; gvv[2 * n] = cvtpk(gq[0], gq[1]); gvv[2 * n + 1] = cvtpk(gq[2], gq[3]); }
                    }
                    wo.x = wv[0]; wo.y = wv[1]; wo.z = wv[2]; wo.w = wv[3];
                    *(u32x4*)(act + (size_t)row * 2816 + ch0) = wo;
                    const int r64 = (m * 16 + lane16);
                    if (r64 < 2 || r64 >= 62) {
                        wu.x = uvv[0]; wu.y = uvv[1]; wu.z = uvv[2]; wu.w = uvv[3]; wg.x = gvv[0]; wg.y = gvv[1]; wg.z = gvv[2]; wg.w = gvv[3];
                        bf16_t* sbr = sb + ((size_t)(row >> 6) * 4 + ((r64 < 2) ? r64 + 2 : r64 - 62)) * 5632 + ch0;
                        *(u32x4*)sbr = wu; *(u32x4*)(sbr + 2816) = wg;
                    }
                }
            }
            return;
        }
        float rsv[2][4];
        {
            f32x4 sv[2][4];
#pragma unroll
            for (int ai = 0; ai < 2; ++ai)
#pragma unroll
                for (int m = 0; m < 4; ++m) sv[ai][m] = *(const f32x4*)(ssq + (size_t)(rowb + ai * 128 + m * 16) * 16 + 4 * fq);
#pragma unroll
            for (int ai = 0; ai < 2; ++ai)
#pragma unroll
                for (int m = 0; m < 4; ++m) {
                    float ss = (sv[ai][m][0] + sv[ai][m][1]) + (sv[ai][m][2] + sv[ai][m][3]);
                    ss += __shfl_xor(ss, 16); ss += __shfl_xor(ss, 32);
                    rsv[ai][m] = rsqrtf(ss * (1.0f / DM) + EPS);
                }
        }
#pragma unroll
        for (int ai = 0; ai < 2; ++ai)
#pragma unroll
            for (int m = 0; m < 4; ++m) {
                const int row = rowb + ai * 128 + m * 16;
                const float rs = rsv[ai][m];
                f32x4 v[2][2];
#pragma unroll
                for (int bj = 0; bj < 2; ++bj) { v[bj][0] = acc[ai][bj][m][0] * rs; v[bj][1] = acc[ai][bj][m][1] * rs; }
                if (mode == 1 && u.pn < 8) {
                    const int pos = row & seqmask; const int i0 = wc * 32 + 8 * fq;
#pragma unroll
                    for (int n = 0; n < 2; ++n) {
                        const int ti = ((wc < 2) ? RR_ROW + (pos >> 6) * 64 + i0 : RR_COL + (pos & 63) * 64 + (i0 - 64)) + 4 * n;
                        const f32x4 c = *(const f32x4*)(cosr + ti), s = *(const f32x4*)(cosr + ROPE_N + ti);
                        const f32x4 x1 = v[0][n], x2 = v[1][n];
                        v[0][n] = x1 * c - x2 * s; v[1][n] = x2 * c + x1 * s;
                    }
                }
                if (mode == 0 && u.pn < 3) {
                    const int hh = 4 * u.pn + wc;
                    if (hh < 10) {
                        float ss = 0.f;
#pragma unroll
                        for (int bj = 0; bj < 2; ++bj)
#pragma unroll
                            for (int n = 0; n < 2; ++n) ss += (v[bj][n][0] * v[bj][n][0] + v[bj][n][1] * v[bj][n][1]) + (v[bj][n][2] * v[bj][n][2] + v[bj][n][3] * v[bj][n][3]);
                        ss += __shfl_xor(ss, 16); ss += __shfl_xor(ss, 32);
                        const float hrs = rsqrtf(ss * (1.0f / 64.0f) + EPS) * ((hh < 8) ? 0.125f * LOG2E : 1.0f);
                        const float* gp = ((hh < 8) ? qn : kn) + 8 * fq;
                        const int pos = row & seqmask;
#pragma unroll
                        for (int n = 0; n < 2; ++n) {
                            const f32x4 g1 = *(const f32x4*)(gp + 4 * n), g2 = *(const f32x4*)(gp + 32 + 4 * n);
                            const int ti = ((fq < 2) ? RA_ROW + (pos >> 6) * 16 + 8 * fq : RA_COL + (pos & 63) * 16 + 8 * (fq - 2)) + 4 * n;
                            const f32x4 c = *(const f32x4*)(cosa + ti), s = *(const f32x4*)(cosa + ROPE_N + ti);
                            const f32x4 y1 = v[0][n] * g1 * hrs, y2 = v[1][n] * g2 * hrs;
                            v[0][n] = y1 * c - y2 * s; v[1][n] = y2 * c + y1 * s;
                        }
                    }
                    bf16_t* orow = O + (size_t)row * ldo + u.pn * 256 + wc * 64 + 8 * fq;
#pragma unroll
                    for (int bj = 0; bj < 2; ++bj) {
                        u32x4 w; w.x = cvtpk(v[bj][0][0], v[bj][0][1]); w.y = cvtpk(v[bj][0][2], v[bj][0][3]); w.z = cvtpk(v[bj][1][0], v[bj][1][1]); w.w = cvtpk(v[bj][1][2], v[bj][1][3]);
                        *(u32x4*)(orow + bj * 32) = w;
                    }
                } else if (mode == 0 && u.pn == 11) {
                    if (wc == 0 && fq < 2) { float* g = gates + (size_t)row * 16 + 8 * fq; *(f32x4*)g = v[0][0]; *(f32x4*)(g + 4) = v[0][1]; }
                } else if (mode == 1 && u.pn < 4) {
                    const int cidx = row >> 7, l = row & 127;
#pragma unroll
                    for (int bj = 0; bj < 2; ++bj) {
                        const int d0 = bj * 128 + wc * 32 + 8 * fq;
                        bf16_t* dst = qt + ((((((size_t)cidx * 4 + u.pn) * 4 + (l >> 5)) * 16 + (d0 >> 4)) * 2 + ((d0 >> 3) & 1)) * 32 + (l & 31)) * 8;
                        u32x4 w; w.x = cvtpk(v[bj][0][0], v[bj][0][1]); w.y = cvtpk(v[bj][0][2], v[bj][0][3]); w.z = cvtpk(v[bj][1][0], v[bj][1][1]); w.w = cvtpk(v[bj][1][2], v[bj][1][3]);
                        *(u32x4*)dst = w;
                    }
                } else {
                    bf16_t* orow = O + (size_t)row * ldo + colb - colsub;
#pragma unroll
                    for (int bj = 0; bj < 2; ++bj) {
                        u32x4 w; w.x = cvtpk(v[bj][0][0], v[bj][0][1]); w.y = cvtpk(v[bj][0][2], v[bj][0][3]); w.z = cvtpk(v[bj][1][0], v[bj][1][1]); w.w = cvtpk(v[bj][1][2], v[bj][1][3]);
                        *(u32x4*)(orow + bj * 128) = w;
                    }
                }
            }
    }
};
struct WDesc { const float* W; int K, N; bf16_t* WT; const float* gain; int cs_lo, cs_hi; float cs; int perm_up, perm_ab; };
__device__ __forceinline__ void get_wdesc(const Params& p, int m, WDesc& d) {
    unsigned char* ws = p.ws;
    d.gain = nullptr; d.cs_lo = 0; d.cs_hi = 0; d.cs = 1.f; d.perm_up = 0; d.perm_ab = 0;
    if (m < 2) { const int j = m; d.W = p.in[5] + (size_t)j * 1024 * 2832; d.K = 1024; d.N = 2832; d.WT = (bf16_t*)(ws + W_ABIN + j * W_ABIN_SZ); d.gain = p.in[2] + (2 * j) * 1024; d.cs_lo = 1280; d.cs_hi = 1792; d.cs = 0.08838834764831845f; d.perm_ab = 1; }
    else if (m < 4) { const int j = m - 2; d.W = p.in[10] + (size_t)j * 1024 * 1024; d.K = 1024; d.N = 1024; d.WT = (bf16_t*)(ws + W_ABOUT + j * W_ABOUT_SZ); }
    else if (m < 6) { const int j = m - 4; d.W = p.in[11] + (size_t)j * 1024 * 6144; d.K = 1024; d.N = 6144; d.WT = (bf16_t*)(ws + W_RETIN + j * W_RETIN_SZ); d.gain = p.in[2] + (2 * j + 1) * 1024; d.cs_lo = 1024; d.cs_hi = 2048; d.cs = 0.0625f; }
    else if (m < 8) { const int j = m - 6; d.W = p.in[14] + (size_t)j * 2048 * 1024; d.K = 2048; d.N = 1024; d.WT = (bf16_t*)(ws + W_RETOUT + j * W_RETOUT_SZ); }
    else if (m < 12) { const int l = m - 8; d.W = p.in[15] + (size_t)l * 1024 * 5632; d.K = 1024; d.N = 5632; d.WT = (bf16_t*)(ws + W_UP + l * W_UP_SZ); d.gain = p.in[3] + l * 1024; d.perm_up = 1; }
    else { const int l = m - 12; d.W = p.in[18] + (size_t)l * 2816 * 1024; d.K = 2816; d.N = 1024; d.WT = (bf16_t*)(ws + W_DOWN + l * W_DOWN_SZ); }
}
__device__ __forceinline__ void transpose_item(const WDesc& d, LAS float* scr, int item, int lane) {
    const int nblk = (d.N + 31) / 32, kb = item / nblk, nb = item % nblk, k0 = 64 * kb, n0 = 32 * nb;
    const int nq = n0 + 4 * (lane & 7);
#pragma unroll
    for (int i = 0; i < 8; ++i) {
        const int kk = i * 8 + (lane >> 3);
        f32x4 v = {0.f, 0.f, 0.f, 0.f};
        if (nq < d.N) v = *(const f32x4*)(d.W + (size_t)(k0 + kk) * d.N + nq);
        if (d.gain) v = v * d.gain[k0 + kk];
        LAS float* sp = scr + kk * 33 + 4 * (lane & 7);
        sp[0] = v[0]; sp[1] = v[1]; sp[2] = v[2]; sp[3] = v[3];
    }
    asm volatile("s_waitcnt lgkmcnt(0)" ::: "memory");
    const int c = lane & 7;
#pragma unroll
    for (int j = 0; j < 4; ++j) { const int n = (lane >> 3) + 8 * j; const LAS float* s = scr + (8 * c) * 33 + n;
        const float sc = (n0 + n >= d.cs_lo && n0 + n < d.cs_hi) ? d.cs : 1.f;
        u32x4 o; o.x = cvtpk(s[0 * 33] * sc, s[1 * 33] * sc); o.y = cvtpk(s[2 * 33] * sc, s[3 * 33] * sc); o.z = cvtpk(s[4 * 33] * sc, s[5 * 33] * sc); o.w = cvtpk(s[6 * 33] * sc, s[7 * 33] * sc);
        int orow = n0 + n;
        if (d.perm_ab && orow < 768) { const int rem = orow & 255; orow = (orow & ~255) + 128 * ((rem >> 5) & 1) + 32 * (rem >> 6) + (rem & 31); }
        if (d.perm_up) { const int isg = orow >= 2816, chn = orow - (isg ? 2816 : 0); orow = (chn >> 7) * 256 + isg * 128 + (chn & 127); }
        *(u32x4*)(d.WT + (size_t)orow * d.K + k0 + 8 * c) = o; }
    asm volatile("s_waitcnt lgkmcnt(0)" ::: "memory");
}
__device__ __forceinline__ void sincos_d(double a, float& c, float& s) {
    const double INV_TWO_PI = 0.15915494309189533577, TWO_PI = 6.283185307179586476925;
    const double k = rint(a * INV_TWO_PI); const double r = (a - k * TWO_PI) * 0.5;
    const double r2 = r * r;
    double sn = 1.0, cs = 1.0, ts = 1.0, tc = 1.0;
#pragma unroll
    for (int i = 1; i <= 12; ++i) { constexpr double one = 1.0; tc *= -r2 * (one / (double)((2 * i - 1) * (2 * i))); ts *= -r2 * (one / (double)((2 * i) * (2 * i + 1))); cs += tc; sn += ts; }
    sn *= r;
    s = (float)(2.0 * sn * cs); c = (float)(1.0 - 2.0 * sn * sn);
}
__device__ __forceinline__ void prologue_phase(const Params& p, LAS unsigned char* lds, int tid, int wave, int lane) {
    LAS float* scr = (LAS float*)(lds + wave * 16384);
    const int gw = blockIdx.x * 8 + wave, NGW = gridDim.x * 8;
    int base = 0;
    for (int m = 0; m < 16; ++m) {
        WDesc d; get_wdesc(p, m, d);
        const int nitems = (d.K / 64) * ((d.N + 31) / 32);
        int first = (gw - base % NGW + NGW) % NGW;
        for (int it = first; it < nitems; it += NGW) transpose_item(d, scr, it, lane);
        base += nitems;
    }
    float* tab = (float*)(p.ws + WS_ROPE);
    const int gt = blockIdx.x * NTHREADS + tid, NGT = gridDim.x * NTHREADS;
    const double LN_THETA = 9.210340371976182736;
    for (int e = gt; e < ROPE_N; e += NGT) {
        int nf, f, idx;
        if (e < RA_COL) { nf = 16; f = e & 15; idx = e >> 4; }
        else if (e < RR_ROW) { nf = 16; f = (e - RA_COL) & 15; idx = (e - RA_COL) >> 4; }
        else if (e < RR_COL) { nf = 64; f = (e - RR_ROW) & 63; idx = (e - RR_ROW) >> 6; }
        else { nf = 64; f = (e - RR_COL) & 63; idx = (e - RR_COL) >> 6; }
        const double inv = exp(-(double)f / (double)nf * LN_THETA);
        float c, s; sincos_d((double)idx * inv, c, s); tab[e] = c; tab[ROPE_N + e] = s;
    }
}
__device__ __forceinline__ void chunk_start_phase(const Params& p, int chunk, int do_start, int do_final, int wave, int lane) {
    const int gw = blockIdx.x * 8 + wave, NGW = gridDim.x * 8;
    float* ssq = (float*)(p.ws + WS_SSQ);
    if (do_start) {
        const float* xin = (chunk == 0) ? p.in[0] : p.in[1] + (size_t)(chunk - 1) * CH_ROWS * DM;
        bf16_t* xb = (bf16_t*)(p.ws + WS_XB);
        for (int r0 = 2 * gw; r0 < CH_ROWS; r0 += 2 * NGW) {
            f32x4 v[2][4];
#pragma unroll
            for (int q = 0; q < 2; ++q) { const f32x4* src = (const f32x4*)(xin + (size_t)(r0 + q) * DM) + lane;
#pragma unroll
                for (int j = 0; j < 4; ++j) v[q][j] = src[64 * j]; }
#pragma unroll
            for (int q = 0; q < 2; ++q) {
                u32x2* db = (u32x2*)(xb + (size_t)(r0 + q) * DM) + lane; float ss = 0.f;
#pragma unroll
                for (int j = 0; j < 4; ++j) { const f32x4 x = v[q][j]; u32x2 w; w.x = cvtpk(x[0], x[1]); w.y = cvtpk(x[2], x[3]); db[64 * j] = w; ss += (x[0] * x[0] + x[1] * x[1]) + (x[2] * x[2] + x[3] * x[3]); }
                ss = wave_sum(ss);
                if (lane < 16) ssq[(size_t)(chunk * CH_ROWS + r0 + q) * 16 + lane] = (lane == 0) ? ss : 0.f;
            }
        }
    }
    if (do_final) {
        const int pc = do_start ? chunk - 1 : chunk;
        const f32x4* g = (const f32x4*)p.in[4] + lane;
        f32x4 gv[4];
#pragma unroll
        for (int j = 0; j < 4; ++j) gv[j] = g[64 * j];
        for (int r0 = 2 * gw; r0 < CH_ROWS; r0 += 2 * NGW) {
            f32x4 v[2][4]; float sv[2];
#pragma unroll
            for (int q = 0; q < 2; ++q) { const size_t row = (size_t)pc * CH_ROWS + r0 + q; sv[q] = (lane < 16) ? ssq[row * 16 + lane] : 0.f; const f32x4* xr = (const f32x4*)(p.out + row * DM) + lane;
#pragma unroll
                for (int j = 0; j < 4; ++j) v[q][j] = xr[64 * j]; }
#pragma unroll
            for (int q = 0; q < 2; ++q) { const size_t row = (size_t)pc * CH_ROWS + r0 + q; const float rs = rsqrtf(wave_sum(sv[q]) * (1.0f / DM) + EPS); f32x4* xr = (f32x4*)(p.out + row * DM) + lane;
#pragma unroll
                for (int j = 0; j < 4; ++j) xr[64 * j] = v[q][j] * rs * gv[j]; }
        }
    }
}
constexpr int LDP_AB = 3072;
__device__ __forceinline__ void prep_phase(const Params& p, int j, int seq_len, int wave, int lane) {
    bf16_t* P = (bf16_t*)(p.ws + WS_BIG1);
    const float qg = p.in[7][j * 64 + lane], kg = p.in[8][j * 64 + lane];
    const float* cosA = (const float*)(p.ws + WS_ROPE); const float* sinA = cosA + 8192 * 32;
    const int gw = blockIdx.x * 8 + wave, NGW = gridDim.x * 8;
    for (int row = gw; row < CH_ROWS; row += NGW) {
        bf16_t* ptr = P + (size_t)row * LDP_AB + lane;
        float x[10];
#pragma unroll
        for (int hh = 0; hh < 10; ++hh) x[hh] = bf2f(ptr[hh * 64]);
        const int pos = row & (seq_len - 1);
        const float c = cosA[pos * 32 + (lane & 31)], s = sinA[pos * 32 + (lane & 31)];
#pragma unroll
        for (int hh = 0; hh < 10; ++hh) {
            const float ss = wave_sum(x[hh] * x[hh]);
            const float rs = rsqrtf(ss * (1.0f / 64.0f) + EPS);
            const float y = x[hh] * rs * ((hh < 8) ? qg : kg);
            const float pr = __shfl_xor(y, 32);
            float o = (lane < 32) ? (y * c - pr * s) : (y * c + pr * s);
            if (hh < 8) o *= 0.125f * LOG2E;
            x[hh] = o;
        }
#pragma unroll
        for (int hh = 0; hh < 10; ++hh) ptr[hh * 64] = f2bf(x[hh]);
    }
}

__device__ __forceinline__ void attn_softmax_tile(f32x16& s0, f32x16& s1, float& l_run) {
    float ps = 0.f;
#pragma unroll
    for (int i = 0; i < 16; ++i) { s0[i] = __builtin_amdgcn_exp2f(s0[i]); s1[i] = __builtin_amdgcn_exp2f(s1[i]); ps += s0[i] + s1[i]; }
    l_run += ps;
}
__device__ __forceinline__ void attn_store_tile(bf16_t* orow, const f32x16& o0, const f32x16& o1, float l_run) {
    l_run += __shfl_xor(l_run, 32);
    const float inv = 1.f / l_run;
#pragma unroll
    for (int g = 0; g < 4; ++g) {
        u32x2 w0; w0.x = cvtpk(o0[4 * g] * inv, o0[4 * g + 1] * inv); w0.y = cvtpk(o0[4 * g + 2] * inv, o0[4 * g + 3] * inv);
        u32x2 w1; w1.x = cvtpk(o1[4 * g] * inv, o1[4 * g + 1] * inv); w1.y = cvtpk(o1[4 * g + 2] * inv, o1[4 * g + 3] * inv);
        *(u32x2*)(orow + 8 * g) = w0; *(u32x2*)(orow + 32 + 8 * g) = w1;
    }
}
__device__ __forceinline__ void attn_unit(const bf16_t* P, bf16_t* MO, LAS unsigned char* lds, int seq_len, int b, int hk, int qb, int tid, int wave, int lane, float negC) {
    constexpr int LD = 72, LDV = 96, TK = 128;
    LAS bf16_t* Kl = (LAS bf16_t*)lds;
    LAS bf16_t* Vl = Kl + 2 * TK * LD;
    const int rowbase = b * seq_len;
    const int r = lane & 31, h = lane >> 5;
    const int hq = hk * 4 + (wave >> 1);
    const int tq = rowbase + qb * 128 + 64 * (wave & 1) + r;
    bf16x8 qfA[4], qfB[4];
#pragma unroll
    for (int s = 0; s < 4; ++s) { qfA[s] = *(const bf16x8*)(P + (size_t)tq * LDP_AB + hq * 64 + 16 * s + 8 * h); qfB[s] = *(const bf16x8*)(P + (size_t)(tq + 32) * LDP_AB + hq * 64 + 16 * s + 8 * h); }
    const int skey = tid >> 3, sch = tid & 7;
    const bf16_t* kp = P + (size_t)(rowbase + skey) * LDP_AB + 512 + hk * 64 + sch * 8;
    const bf16_t* vp = P + (size_t)(rowbase + skey) * LDP_AB + 640 + hk * 64 + sch * 8;
    u32x4 kr0 = *(const u32x4*)kp, vr0 = *(const u32x4*)vp;
    { const u32x4 kr1 = *(const u32x4*)(kp + (size_t)64 * LDP_AB), vr1 = *(const u32x4*)(vp + (size_t)64 * LDP_AB);
      *(LAS u32x4*)(Kl + skey * LD + sch * 8) = kr0; *(LAS u32x4*)(Vl + skey * LDV + sch * 8) = vr0;
      *(LAS u32x4*)(Kl + (skey + 64) * LD + sch * 8) = kr1; *(LAS u32x4*)(Vl + (skey + 64) * LDV + sch * 8) = vr1; }
    __syncthreads();
    float lA = 0.f, lB = 0.f;
    f32x16 oA0 = {}, oA1 = {}, oB0 = {}, oB1 = {};
    const int ntile = seq_len / TK;
    for (int it = 0; it < ntile; ++it) {
        const int cur = it & 1;
#pragma unroll 1
        for (int sub = 0; sub < 2; ++sub) {
            if (it + 1 < ntile) { const size_t off = (size_t)((it + 1) * TK + sub * 64) * LDP_AB; kr0 = *(const u32x4*)(kp + off); vr0 = *(const u32x4*)(vp + off); }
            const LAS bf16_t* Kc = Kl + (cur * TK + sub * 64) * LD; const LAS bf16_t* Vc = Vl + (cur * TK + sub * 64) * LDV;
            f32x16 sA0 = {}, sA1 = {}, sB0 = {}, sB1 = {};
#pragma unroll
            for (int s = 0; s < 4; ++s) {
                const bf16x8 k0 = lds_rows(Kc, LD, 0, 16 * s, lane), k1 = lds_rows(Kc, LD, 32, 16 * s, lane);
                sA0 = mfma32(k0, qfA[s], sA0); sA1 = mfma32(k1, qfA[s], sA1); sB0 = mfma32(k0, qfB[s], sB0); sB1 = mfma32(k1, qfB[s], sB1);
            }
            if (negC != 0.f) {
#pragma unroll
                for (int i = 0; i < 16; ++i) { sA0[i] += negC; sA1[i] += negC; sB0[i] += negC; sB1[i] += negC; }
            }
            attn_softmax_tile(sA0, sA1, lA);
            attn_softmax_tile(sB0, sB1, lB);
#pragma unroll
            for (int s = 0; s < 2; ++s) {
                const bf16x8 pA0 = pack8(sA0, s), pA1 = pack8(sA1, s), pB0 = pack8(sB0, s), pB1 = pack8(sB1, s);
                const bf16x8 v00 = lds_tr_perm(Vc, LDV, 16 * s, 0, lane), v01 = lds_tr_perm(Vc, LDV, 16 * s, 32, lane);
                oA0 = mfma32(v00, pA0, oA0); oA1 = mfma32(v01, pA0, oA1); oB0 = mfma32(v00, pB0, oB0); oB1 = mfma32(v01, pB0, oB1);
                const bf16x8 v10 = lds_tr_perm(Vc, LDV, 32 + 16 * s, 0, lane), v11 = lds_tr_perm(Vc, LDV, 32 + 16 * s, 32, lane);
                oA0 = mfma32(v10, pA1, oA0); oA1 = mfma32(v11, pA1, oA1); oB0 = mfma32(v10, pB1, oB0); oB1 = mfma32(v11, pB1, oB1);
            }
            if (it + 1 < ntile) {
                LAS bf16_t* Kn = Kl + ((cur ^ 1) * TK + sub * 64) * LD; LAS bf16_t* Vn = Vl + ((cur ^ 1) * TK + sub * 64) * LDV;
                *(LAS u32x4*)(Kn + skey * LD + sch * 8) = kr0; *(LAS u32x4*)(Vn + skey * LDV + sch * 8) = vr0;
            }
        }
        __syncthreads();
    }
    attn_store_tile(MO + (size_t)tq * 1024 + hq * 64 + 4 * h, oA0, oA1, lA);
    attn_store_tile(MO + (size_t)(tq + 32) * 1024 + hq * 64 + 4 * h, oB0, oB1, lB);
}

constexpr size_t ML_U = 64 * MiB, ML_N = 96 * MiB, ML_S = 97 * MiB;
__device__ __forceinline__ int ml_unit(int w, int nchunk) {
    const int pk = w >> 1, dir = w & 1, oc = pk % nchunk, sh = pk / nchunk;
    return (sh * 2 + dir) * nchunk + (dir ? nchunk - 1 - oc : oc);
}
__device__ __forceinline__ void mlstm_gate_load(const Params& p, int j, const float* gates, int rowbase, int seq_len, int c, int dir, int head, int l, LAS float* a_k, LAS float* b_l) {
    const float* gbias = p.in[6] + j * 16;
    const int tok = dir ? (seq_len - 1 - (c * 128 + l)) : (c * 128 + l);
    const float* g = gates + (size_t)(rowbase + tok) * 16;
    const float ig = g[(2 * dir) * 4 + head] + gbias[(2 * dir) * 4 + head];
    const float fp = g[(2 * dir + 1) * 4 + head] + gbias[(2 * dir + 1) * 4 + head];
    a_k[l] = ig; b_l[l] = logsigmoidf_(fp);
}
__device__ __forceinline__ void mlstm_local_phase(const Params& p, int j, LAS unsigned char* lds, int seq_len, int tid_in, int wave) {
    constexpr int LD = 136;
    const bf16_t* P = (const bf16_t*)(p.ws + WS_BIG1);
    const float* gates = (const float*)(p.ws + WS_GATES);
    LAS bf16_t* Kl = (LAS bf16_t*)lds; LAS bf16_t* Vl = Kl + 128 * LD;
    LAS float* fs = (LAS float*)(lds + 4 * 128 * LD * 2);
    LAS float* a_k = fs; LAS float* b_l = fs + 128; LAS float* wk = fs + 384; LAS float* npart = fs + 640;
    bf16_t* U = (bf16_t*)(p.ws + WS_BIG2 + ML_U); float* NL = (float*)(p.ws + WS_BIG2 + ML_N); float* SC = (float*)(p.ws + WS_BIG2 + ML_S);
    const int nchunk = seq_len / 128;
    const float* gbias = p.in[6] + j * 16;
    u32x4 pk[4], pv[4]; float pig = 0.f, pfp = 0.f;
#define MLL_LOAD(UU) do { const int c_ = (UU) % nchunk, sidx_ = (UU) / nchunk, dir_ = sidx_ & 1, head_ = (sidx_ >> 1) & 3, rowbase_ = (sidx_ >> 3) * seq_len; \
        _Pragma("unroll") for (int i = 0; i < 4; ++i) { const int piece = tid + NTHREADS * i, l = piece >> 4, ch = piece & 15; \
            const int tok = dir_ ? (seq_len - 1 - (c_ * 128 + l)) : (c_ * 128 + l); \
            const bf16_t* src = P + (size_t)(rowbase_ + tok) * LDP_AB + head_ * 128 + ch * 8; \
            pk[i] = *(const u32x4*)(src + 1280); pv[i] = *(const u32x4*)(src + 1792); } \
        if (tid < 128) { const int tok = dir_ ? (seq_len - 1 - (c_ * 128 + tid)) : (c_ * 128 + tid); const float* g = gates + (size_t)(rowbase_ + tok) * 16; \
            pig = g[(2 * dir_) * 4 + head_] + gbias[(2 * dir_) * 4 + head_]; pfp = g[(2 * dir_ + 1) * 4 + head_] + gbias[(2 * dir_ + 1) * 4 + head_]; } } while (0)
    const int upb = (1024 + gridDim.x - 1) / gridDim.x;
    { const int tid = tid_in; if ((int)blockIdx.x * upb < 1024) { const int u0_ = ml_unit(blockIdx.x * upb, nchunk); MLL_LOAD(u0_); } }
    for (int wi = 0; wi < upb && (int)blockIdx.x * upb + wi < 1024; ++wi) {
        const int uidx = ml_unit(blockIdx.x * upb + wi, nchunk);
        int tid = tid_in; asm volatile("" : "+v"(tid)); const int lane = tid & 63, r = lane & 31, h = lane >> 5;
#pragma unroll
        for (int i = 0; i < 4; ++i) {
            const int piece = tid + NTHREADS * i, l = piece >> 4, ch = piece & 15;
            *(LAS u32x4*)(Kl + l * LD + ch * 8) = pk[i];
            *(LAS u32x4*)(Vl + l * LD + ch * 8) = pv[i];
        }
        if (tid < 128) { a_k[tid] = pig; b_l[tid] = logsigmoidf_(pfp); }
        __syncthreads();
        if (wi + 1 < upb && (int)blockIdx.x * upb + wi + 1 < 1024) { const int un_ = ml_unit(blockIdx.x * upb + wi + 1, nchunk); MLL_LOAD(un_); }
        if (wave == 0) {
            const float lf0 = b_l[2 * lane], lf1 = b_l[2 * lane + 1], ig0 = a_k[2 * lane], ig1 = a_k[2 * lane + 1];
            const float s1 = lf0 + lf1; float x = s1;
#pragma unroll
            for (int off = 1; off < 64; off <<= 1) { const float y = __shfl_up(x, off); if (lane >= off) x += y; }
            const float excl = x - s1, b0 = excl + lf0, b1 = excl + s1;
            const float a0 = ig0 - b0, a1 = ig1 - b1;
            float mxx = fmaxf(a0, a1);
#pragma unroll
            for (int off = 1; off < 64; off <<= 1) mxx = fmaxf(mxx, __shfl_xor(mxx, off));
            wk[2 * lane] = __expf(a0 - mxx); wk[2 * lane + 1] = __expf(a1 - mxx);
            if (lane == 63) { SC[(size_t)uidx * 4 + 0] = mxx; SC[(size_t)uidx * 4 + 1] = b1; }
        }
        __syncthreads();
#pragma unroll
        for (int i = 0; i < 4; ++i) {
            const int piece = tid + NTHREADS * i, l = piece >> 4, ch = piece & 15;
            const float w = wk[l];
            u32x4 v = *(LAS u32x4*)(Vl + l * LD + ch * 8);
            v.x = cvtpk(bflo(v.x) * w, bfhi(v.x) * w); v.y = cvtpk(bflo(v.y) * w, bfhi(v.y) * w); v.z = cvtpk(bflo(v.z) * w, bfhi(v.z) * w); v.w = cvtpk(bflo(v.w) * w, bfhi(v.w) * w);
            *(LAS u32x4*)(Vl + l * LD + ch * 8) = v;
        }
        { const int d = tid & 127, kq = tid >> 7; float acc = 0.f;
#pragma unroll 8
          for (int k = kq * 32; k < kq * 32 + 32; ++k) acc += wk[k] * bf2f(Kl[k * LD + d]);
          npart[kq * 128 + d] = acc; }
        __syncthreads();
        {
            const int et = wave >> 1, dt0 = 2 * (wave & 1);
            f32x16 c0 = {}, c1 = {};
#pragma unroll
            for (int s = 0; s < 8; ++s) { const bf16x8 A = lds_tr(Vl, LD, 16 * s, 32 * et, lane);
                c0 = mfma32(A, lds_tr(Kl, LD, 16 * s, 32 * dt0, lane), c0); c1 = mfma32(A, lds_tr(Kl, LD, 16 * s, 32 * dt0 + 32, lane), c1); }
            bf16_t* Uu = U + (size_t)uidx * 16384;
#pragma unroll
            for (int g = 0; g < 4; ++g) {
                u32x2 w0; w0.x = cvtpk(c0[4 * g], c0[4 * g + 1]); w0.y = cvtpk(c0[4 * g + 2], c0[4 * g + 3]);
                u32x2 w1; w1.x = cvtpk(c1[4 * g], c1[4 * g + 1]); w1.y = cvtpk(c1[4 * g + 2], c1[4 * g + 3]);
                *(u32x2*)(Uu + (32 * dt0 + r) * 128 + 32 * et + 8 * g + 4 * h) = w0;
                *(u32x2*)(Uu + (32 * dt0 + 32 + r) * 128 + 32 * et + 8 * g + 4 * h) = w1;
            }
            if (tid < 128) NL[(size_t)uidx * 128 + tid] = (npart[tid] + npart[128 + tid]) + (npart[256 + tid] + npart[384 + tid]);
        }
        __syncthreads();
    }
#undef MLL_LOAD
}
__device__ __forceinline__ void mlstm_combine_phase(const Params& p, LAS unsigned char* lds, int seq_len, int tid) {
    unsigned* U = (unsigned*)(p.ws + WS_BIG2 + ML_U); float* NL = (float*)(p.ws + WS_BIG2 + ML_N); float* SC = (float*)(p.ws + WS_BIG2 + ML_S);
    LAS float* keepv = (LAS float*)lds; LAS float* scv = keepv + 64;
    const int nchunk = seq_len / 128, nscan = 1024 / nchunk;
    for (int sl = blockIdx.x; sl < nscan * 16; sl += gridDim.x) {
        const int sidx = sl >> 4, eb = sl & 15;
        const size_t u0 = (size_t)sidx * nchunk;
        if (tid < 64) {
            const float pmv = (tid < nchunk) ? SC[(u0 + tid) * 4 + 0] : 0.f, blv = (tid < nchunk) ? SC[(u0 + tid) * 4 + 1] : 0.f;
            float m = 0.f, mst = 0.f;
            for (int c = 0; c < nchunk; ++c) {
                const float pm = __shfl(pmv, c), bl = __shfl(blv, c);
                const float Ml = fmaxf(m, pm);
                if (tid == c) { keepv[c] = __expf(m - Ml); scv[c] = __expf(pm - Ml); mst = m; }
                m = bl + Ml;
            }
            if (tid < nchunk && eb == 0) SC[(u0 + tid) * 4 + 2] = mst;
        }
        __syncthreads();
        unsigned* up = U + u0 * 8192 + eb * 512 + tid;
        float C0 = 0.f, C1 = 0.f;
        for (int c0 = 0; c0 < nchunk; c0 += 8) {
            unsigned uu[8];
#pragma unroll
            for (int i = 0; i < 8; ++i) uu[i] = up[(size_t)(c0 + i) * 8192];
#pragma unroll
            for (int i = 0; i < 8; ++i) { up[(size_t)(c0 + i) * 8192] = cvtpk(C0, C1); const float kp = keepv[c0 + i], sc = scv[c0 + i]; C0 = kp * C0 + sc * bflo(uu[i]); C1 = kp * C1 + sc * bfhi(uu[i]); }
        }
        if (eb == 0 && tid < 128) {
            float* np = NL + u0 * 128 + tid; float nn = 0.f;
            for (int c0 = 0; c0 < nchunk; c0 += 8) {
                float nl[8];
#pragma unroll
                for (int i = 0; i < 8; ++i) nl[i] = np[(size_t)(c0 + i) * 128];
#pragma unroll
                for (int i = 0; i < 8; ++i) { np[(size_t)(c0 + i) * 128] = nn; nn = keepv[c0 + i] * nn + scv[c0 + i] * nl[i]; }
            }
        }
        __syncthreads();
    }
}
__device__ __forceinline__ void mlstm_out_phase(const Params& p, int j, LAS unsigned char* lds, int seq_len, int tid_in, int wave) {
    constexpr int LD = 136;
    const bf16_t* P = (const bf16_t*)(p.ws + WS_BIG1);
    const float* gates = (const float*)(p.ws + WS_GATES);
    LAS bf16_t* Ql = (LAS bf16_t*)lds; LAS bf16_t* Kl = Ql + 128 * LD; LAS bf16_t* Vl = Kl + 128 * LD; LAS bf16_t* Cl = Vl + 128 * LD;
    LAS float* fs = (LAS float*)(lds + 4 * 128 * LD * 2);
    LAS float* a_k = fs; LAS float* b_l = fs + 128; LAS float* M_l = fs + 256; LAS float* nvec = fs + 512; LAS float* scal = fs + 1152;
    const bf16_t* U = (const bf16_t*)(p.ws + WS_BIG2 + ML_U); const float* NL = (const float*)(p.ws + WS_BIG2 + ML_N); const float* SC = (const float*)(p.ws + WS_BIG2 + ML_S);
    const int nchunk = seq_len / 128;
    const float* gbias = p.in[6] + j * 16;
    u32x4 pq[4], pk[4], pv[4], pc[4]; float pig = 0.f, pfp = 0.f, pnv = 0.f, pm = 0.f;
#define MLO_LOAD(UU) do { const int c_ = (UU) % nchunk, sidx_ = (UU) / nchunk, dir_ = sidx_ & 1, head_ = (sidx_ >> 1) & 3, rowbase_ = (sidx_ >> 3) * seq_len; \
        _Pragma("unroll") for (int i = 0; i < 4; ++i) { const int piece = tid + NTHREADS * i, l = piece >> 4, ch = piece & 15; \
            const int tok = dir_ ? (seq_len - 1 - (c_ * 128 + l)) : (c_ * 128 + l); \
            const bf16_t* src = P + (size_t)(rowbase_ + tok) * LDP_AB + head_ * 128 + ch * 8; \
            pq[i] = *(const u32x4*)(src + 768); pk[i] = *(const u32x4*)(src + 1280); pv[i] = *(const u32x4*)(src + 1792); \
            pc[i] = *(const u32x4*)(U + (size_t)(UU) * 16384 + l * 128 + ch * 8); } \
        if (tid < 128) { const int tok = dir_ ? (seq_len - 1 - (c_ * 128 + tid)) : (c_ * 128 + tid); const float* g = gates + (size_t)(rowbase_ + tok) * 16; \
            pig = g[(2 * dir_) * 4 + head_] + gbias[(2 * dir_) * 4 + head_]; pfp = g[(2 * dir_ + 1) * 4 + head_] + gbias[(2 * dir_ + 1) * 4 + head_]; pnv = NL[(size_t)(UU) * 128 + tid]; } \
        pm = SC[(size_t)(UU) * 4 + 2]; } while (0)
    const int upb = (1024 + gridDim.x - 1) / gridDim.x;
    { const int tid = tid_in; if ((int)blockIdx.x * upb < 1024) { const int u0_ = ml_unit(blockIdx.x * upb, nchunk); MLO_LOAD(u0_); } }
    for (int wi = 0; wi < upb && (int)blockIdx.x * upb + wi < 1024; ++wi) {
        const int uidx = ml_unit(blockIdx.x * upb + wi, nchunk);
        int tid = tid_in; asm volatile("" : "+v"(tid)); const int lane = tid & 63, r = lane & 31, h = lane >> 5;
        const int c = uidx % nchunk, sidx = uidx / nchunk, dir = sidx & 1, head = (sidx >> 1) & 3, b = sidx >> 3;
        const int rowbase = b * seq_len;
        bf16_t* H = (bf16_t*)(p.ws + WS_BIG2 + (dir ? 48 : 32) * MiB);
#pragma unroll
        for (int i = 0; i < 4; ++i) {
            const int piece = tid + NTHREADS * i, l = piece >> 4, ch = piece & 15;
            *(LAS u32x4*)(Ql + l * LD + ch * 8) = pq[i]; *(LAS u32x4*)(Kl + l * LD + ch * 8) = pk[i];
            *(LAS u32x4*)(Vl + l * LD + ch * 8) = pv[i]; *(LAS u32x4*)(Cl + l * LD + ch * 8) = pc[i];
        }
        if (tid < 128) { a_k[tid] = pig; b_l[tid] = logsigmoidf_(pfp); nvec[tid] = pnv; }
        if (tid == 0) scal[0] = pm;
        __syncthreads();
        if (wi + 1 < upb && (int)blockIdx.x * upb + wi + 1 < 1024) { const int un_ = ml_unit(blockIdx.x * upb + wi + 1, nchunk); MLO_LOAD(un_); }
        if (wave == 0) {
            const float lf0 = b_l[2 * lane], lf1 = b_l[2 * lane + 1], ig0 = a_k[2 * lane], ig1 = a_k[2 * lane + 1];
            const float s1 = lf0 + lf1; float x = s1;
#pragma unroll
            for (int off = 1; off < 64; off <<= 1) { const float y = __shfl_up(x, off); if (lane >= off) x += y; }
            const float excl = x - s1, b0 = excl + lf0, b1 = excl + s1;
            const float a0 = ig0 - b0, a1 = ig1 - b1;
            float mxx = fmaxf(a0, a1);
#pragma unroll
            for (int off = 1; off < 64; off <<= 1) { const float y = __shfl_up(mxx, off); if (lane >= off) mxx = fmaxf(mxx, y); }
            float exm = __shfl_up(mxx, 1); if (lane == 0) exm = -1e30f;
            const float m_old = scal[0];
            b_l[2 * lane] = b0; b_l[2 * lane + 1] = b1; a_k[2 * lane] = a0; a_k[2 * lane + 1] = a1;
            M_l[2 * lane] = fmaxf(m_old, fmaxf(exm, a0)); M_l[2 * lane + 1] = fmaxf(m_old, mxx);
        }
        __syncthreads();
        {
            const int qb = wave & 3, eh = wave >> 2, l = 32 * qb + r;
            bf16x8 qf[8];
#pragma unroll
            for (int s = 0; s < 8; ++s) qf[s] = lds_rows(Ql, LD, 32 * qb, 16 * s, lane);
            const float M = M_l[l], m_old = scal[0], bl = b_l[l];
            const float interw = __expf(m_old - M);
            float qn = 0.f;
#pragma unroll
            for (int s = 0; s < 8; ++s)
#pragma unroll
                for (int jj = 0; jj < 8; ++jj) qn += bf2f((bf16_t)qf[s][jj]) * nvec[16 * s + 8 * h + jj];
            qn += __shfl_xor(qn, 32);
            f32x16 o0 = {}, o1 = {};
#pragma unroll
            for (int s = 0; s < 8; ++s) { o0 = mfma32(lds_tr(Cl, LD, 16 * s, eh * 64, lane), qf[s], o0); o1 = mfma32(lds_tr(Cl, LD, 16 * s, eh * 64 + 32, lane), qf[s], o1); }
#pragma unroll
            for (int i = 0; i < 16; ++i) { o0[i] *= interw; o1[i] *= interw; }
            float dsum = 0.f;
            for (int kt = 0; kt <= qb; ++kt) {
                f32x16 sa = {};
#pragma unroll
                for (int s = 0; s < 8; ++s) sa = mfma32(lds_rows(Kl, LD, 32 * kt, 16 * s, lane), qf[s], sa);
#pragma unroll
                for (int i = 0; i < 16; ++i) { const int k = 32 * kt + accrow(i, h); const float w = (k <= l) ? __expf(a_k[k] - M) * sa[i] : 0.f; dsum += w; sa[i] = w; }
#pragma unroll
                for (int s2 = 0; s2 < 2; ++s2) { const bf16x8 wf = pack8(sa, s2);
                    o0 = mfma32(lds_tr_perm(Vl, LD, 32 * kt + 16 * s2, eh * 64, lane), wf, o0);
                    o1 = mfma32(lds_tr_perm(Vl, LD, 32 * kt + 16 * s2, eh * 64 + 32, lane), wf, o1); }
            }
            dsum += __shfl_xor(dsum, 32);
            const float den = dsum + interw * qn;
            const float inv = 1.f / fmaxf(fabsf(den), __expf(-(bl + M)));
            const int tok = dir ? (seq_len - 1 - (c * 128 + l)) : (c * 128 + l);
            bf16_t* hrow = H + (size_t)(rowbase + tok) * 512 + head * 128 + eh * 64 + 4 * h;
#pragma unroll
            for (int g = 0; g < 4; ++g) {
                u32x2 w0; w0.x = cvtpk(o0[4 * g] * inv, o0[4 * g + 1] * inv); w0.y = cvtpk(o0[4 * g + 2] * inv, o0[4 * g + 3] * inv);
                u32x2 w1; w1.x = cvtpk(o1[4 * g] * inv, o1[4 * g + 1] * inv); w1.y = cvtpk(o1[4 * g + 2] * inv, o1[4 * g + 3] * inv);
                *(u32x2*)(hrow + 8 * g) = w0; *(u32x2*)(hrow + 32 + 8 * g) = w1;
            }
        }
        __syncthreads();
    }
#undef MLO_LOAD
}

__device__ __forceinline__ void mix_phase(const Params& p, int j, LAS unsigned char* lds, int seq_len, int tid, int wave, int lane) {
    mlstm_combine_phase(p, lds, seq_len, tid);
    const int nseq = CH_ROWS / seq_len;
    const bf16_t* P = (const bf16_t*)(p.ws + WS_BIG1); bf16_t* MO = (bf16_t*)(p.ws + WS_BIG2);
    const int nqb = seq_len / 128, units = nseq * nqb * 2;
    float negC;
    { float gq = fabsf(p.in[7][j * 64 + lane]), gk = fabsf(p.in[8][j * 64 + lane]);
#pragma unroll
      for (int o = 1; o < 64; o <<= 1) { gq = fmaxf(gq, __shfl_xor(gq, o)); gk = fmaxf(gk, __shfl_xor(gk, o)); }
      negC = -(64.0f * 0.125f * LOG2E * 1.03f) * gq * gk; if (negC > -60.f) negC = 0.f; }
    for (int u0 = blockIdx.x; u0 < units; u0 += gridDim.x) {
        int pair, qb;
        if (gridDim.x == 256) {
            const int x = u0 & 7, idx = u0 >> 3;
            if (nqb == 64) { pair = x >> 1; qb = (x & 1) * 32 + idx; } else { pair = 2 * x + (idx >> 4); qb = idx & 15; }
        } else { pair = u0 / nqb; qb = u0 % nqb; }
        attn_unit(P, MO, lds, seq_len, pair >> 1, pair & 1, qb, tid, wave, lane, negC);
    }
}

__device__ __forceinline__ void fin_ab_phase(const Params& p, int j, int wave, int lane) {
    const bf16_t* P = (const bf16_t*)(p.ws + WS_BIG1); bf16_t* MO = (bf16_t*)(p.ws + WS_BIG2);
    const bf16_t* hf = (const bf16_t*)(p.ws + WS_BIG2 + 32 * MiB); const bf16_t* hb = (const bf16_t*)(p.ws + WS_BIG2 + 48 * MiB);
    const float* gn = p.in[9] + j * 512;
    float g0[4], g1[4];
#pragma unroll
    for (int head = 0; head < 4; ++head) { g0[head] = gn[head * 128 + 2 * lane]; g1[head] = gn[head * 128 + 2 * lane + 1]; }
    const int gw = blockIdx.x * 8 + wave, NGW = gridDim.x * 8;
    for (int row = gw; row < CH_ROWS; row += NGW) {
        unsigned a[4], bb[4], mo[4];
#pragma unroll
        for (int head = 0; head < 4; ++head) {
            a[head] = *(const unsigned*)(hf + (size_t)row * 512 + head * 128 + 2 * lane); bb[head] = *(const unsigned*)(hb + (size_t)row * 512 + head * 128 + 2 * lane);
            mo[head] = *(const unsigned*)(P + (size_t)row * LDP_AB + 2304 + head * 128 + 2 * lane);
        }
#pragma unroll
        for (int head = 0; head < 4; ++head) {
            const float s0 = bflo(a[head]) + bflo(bb[head]), s1 = bfhi(a[head]) + bfhi(bb[head]);
            const float ss = wave_sum(s0 * s0 + s1 * s1);
            const float rs = rsqrtf(ss * (1.0f / 128.0f) + EPS);
            *(unsigned*)(MO + (size_t)row * 1024 + 512 + head * 128 + 2 * lane) = cvtpk(s0 * rs * g0[head] * sigmoidf_(bflo(mo[head])), s1 * rs * g1[head] * sigmoidf_(bfhi(mo[head])));
        }
    }
}
constexpr int LDP_R = 5120;
constexpr size_t QT_OFF = 160 * MiB;
__device__ __forceinline__ void ret_scan(const Params& p, int j, LAS unsigned char* lds, int seq_len, int u, int tid_in, int wave, int variant) {
    constexpr int LDK = 288, LDV = 72;
    const bf16_t* P = (const bf16_t*)(p.ws + WS_BIG1);
    const bf16_t* QT = (const bf16_t*)(p.ws + WS_BIG1 + QT_OFF);
    LAS bf16_t* Kl = (LAS bf16_t*)lds; LAS bf16_t* Vl = Kl + 128 * LDK; LAS bf16_t* Cl = Vl + 128 * LDV;
    const int slice = u & 7, dir = (u >> 3) & 1, head = (u >> 4) & 3, b = u >> 6;
    const int rowbase = b * seq_len;
    bf16_t* Y = (bf16_t*)(p.ws + WS_BIG2 + (dir ? 64 : 0) * MiB);
    const float lg = logsigmoidf_(p.in[12][j * 8 + dir * 4 + head]);
    const float cd = __expf(lg * 128.f);
    f32x16 cacc0 = {}, cacc1 = {};
    for (int i = tid_in; i < 256 * LDV / 2; i += NTHREADS) ((LAS unsigned*)Cl)[i] = 0u;
    const int nchunk = seq_len / 128;
    const int qb = wave & 3, etq = wave >> 2;
    const int etu = wave & 1, dt0 = (wave >> 1) * 2;
    u32x4 kr[8], vr[2]; bf16x8 qf[16];
#define RS_LOADKV(cc) do { _Pragma("unroll") for (int i = 0; i < 8; ++i) { const int piece = tid + NTHREADS * i, l = piece >> 5, ch = piece & 31; \
            const int tok = dir ? (seq_len - 1 - ((cc) * 128 + l)) : ((cc) * 128 + l); \
            kr[i] = *(const u32x4*)(P + (size_t)(rowbase + tok) * LDP_R + head * 256 + ch * 8); } \
        _Pragma("unroll") for (int i = 0; i < 2; ++i) { const int piece = tid + NTHREADS * i, l = piece >> 3, ch = piece & 7; \
            const int tok = dir ? (seq_len - 1 - ((cc) * 128 + l)) : ((cc) * 128 + l); \
            vr[i] = *(const u32x4*)(P + (size_t)(rowbase + tok) * LDP_R + 1024 + head * 512 + slice * 64 + ch * 8); } } while (0)
#define RS_STOREKV() do { _Pragma("unroll") for (int i = 0; i < 8; ++i) { const int piece = tid + NTHREADS * i, l = piece >> 5, ch = piece & 31; *(LAS u32x4*)(Kl + l * LDK + ch * 8) = kr[i]; } \
        _Pragma("unroll") for (int i = 0; i < 2; ++i) { const int piece = tid + NTHREADS * i, l = piece >> 3, ch = piece & 7; u32x4 v = vr[i]; const float w = __expf(lg * (float)(127 - l)); \
            v.x = cvtpk(bflo(v.x) * w, bfhi(v.x) * w); v.y = cvtpk(bflo(v.y) * w, bfhi(v.y) * w); v.z = cvtpk(bflo(v.z) * w, bfhi(v.z) * w); v.w = cvtpk(bflo(v.w) * w, bfhi(v.w) * w); \
            *(LAS u32x4*)(Vl + l * LDV + ch * 8) = v; } } while (0)
#define RS_LOADQ(cc) do { const int oc = dir ? (nchunk - 1 - (cc)) : (cc); const int cidx = (rowbase >> 7) + oc; const int qbo = dir ? 3 - qb : qb, ro = dir ? 31 - r : r; \
        const bf16_t* qsrc = QT + ((((size_t)cidx * 4 + head) * 4 + qbo) * 1024 + h * 32 + ro) * 8; \
        _Pragma("unroll") for (int s = 0; s < 16; ++s) qf[s] = *(const bf16x8*)(qsrc + s * 512); } while (0)
    {
        int tid = tid_in; asm volatile("" : "+v"(tid)); const int lane = tid & 63, r = lane & 31, h = lane >> 5;
        RS_LOADKV(0); RS_LOADQ(0); RS_STOREKV();
        if (nchunk > 1) RS_LOADKV(1);
    }
    __syncthreads();
    for (int c = 0; c < nchunk; ++c) {
        int tid = tid_in; asm volatile("" : "+v"(tid)); const int lane = tid & 63, r = lane & 31, h = lane >> 5;
        const bool more = (c + 1 < nchunk);
        {
            const int lq = 32 * qb + r;
            const int tokq = dir ? (seq_len - 1 - (c * 128 + lq)) : (c * 128 + lq);
            f32x16 o = {}, ob = {};
            if (!(variant & 2)) {
                bf16x8 fa[2][2];
#pragma unroll
                for (int i = 0; i < 2; ++i) fa[0][i] = lds_tr(Cl, LDV, 16 * i, 32 * etq, lane);
#pragma unroll
                for (int sb = 0; sb < 8; ++sb) {
                    if (sb < 7) {
#pragma unroll
                        for (int i = 0; i < 2; ++i) fa[(sb + 1) & 1][i] = lds_tr(Cl, LDV, 16 * (2 * (sb + 1) + i), 32 * etq, lane);
                    }
                    __builtin_amdgcn_sched_barrier(0);
                    o = mfma32(fa[sb & 1][0], qf[2 * sb + 0], o); ob = mfma32(fa[sb & 1][1], qf[2 * sb + 1], ob);
                    __builtin_amdgcn_sched_barrier(0);
                }
#pragma unroll
                for (int i = 0; i < 16; ++i) o[i] += ob[i];
            }
            const float qd = __expf(lg * (float)(lq + 1));
            bf16_t* yrow = Y + (size_t)(rowbase + tokq) * 2048 + head * 512 + slice * 64 + 32 * etq + 4 * h;
#pragma unroll
            for (int g = 0; g < 4; ++g) { u32x2 w0; w0.x = cvtpk(o[4 * g] * qd, o[4 * g + 1] * qd); w0.y = cvtpk(o[4 * g + 2] * qd, o[4 * g + 3] * qd); if (!(variant & 1)) *(u32x2*)(yrow + 8 * g) = w0; else if (w0.x == 0x12345678u && w0.y == 0x9abcdef0u) *(u32x2*)(yrow + 8 * g) = w0; }
        }
        if (more && !(variant & 8)) RS_LOADQ(c + 1);
#pragma unroll
        for (int i = 0; i < 16; ++i) { cacc0[i] *= cd; cacc1[i] *= cd; }
        if (!(variant & 4)) {
            bf16x8 fu[2][3];
            fu[0][0] = lds_tr(Vl, LDV, 0, 32 * etu, lane); fu[0][1] = lds_tr(Kl, LDK, 0, 32 * dt0, lane); fu[0][2] = lds_tr(Kl, LDK, 0, 32 * dt0 + 32, lane);
#pragma unroll
            for (int s = 0; s < 8; ++s) {
                if (s < 7) { fu[(s + 1) & 1][0] = lds_tr(Vl, LDV, 16 * (s + 1), 32 * etu, lane); fu[(s + 1) & 1][1] = lds_tr(Kl, LDK, 16 * (s + 1), 32 * dt0, lane); fu[(s + 1) & 1][2] = lds_tr(Kl, LDK, 16 * (s + 1), 32 * dt0 + 32, lane); }
                __builtin_amdgcn_sched_barrier(0);
                cacc0 = mfma32(fu[s & 1][0], fu[s & 1][1], cacc0); cacc1 = mfma32(fu[s & 1][0], fu[s & 1][2], cacc1);
                __builtin_amdgcn_sched_barrier(0);
            }
        }
        __syncthreads();
#pragma unroll
        for (int g = 0; g < 4; ++g) {
            u32x2 w0; w0.x = cvtpk(cacc0[4 * g], cacc0[4 * g + 1]); w0.y = cvtpk(cacc0[4 * g + 2], cacc0[4 * g + 3]);
            u32x2 w1; w1.x = cvtpk(cacc1[4 * g], cacc1[4 * g + 1]); w1.y = cvtpk(cacc1[4 * g + 2], cacc1[4 * g + 3]);
            *(LAS u32x2*)(Cl + (32 * dt0 + r) * LDV + 32 * etu + 8 * g + 4 * h) = w0;
            *(LAS u32x2*)(Cl + (32 * dt0 + 32 + r) * LDV + 32 * etu + 8 * g + 4 * h) = w1;
        }
        if (more) RS_STOREKV();
        if (c + 2 < nchunk && !(variant & 8)) RS_LOADKV(c + 2);
        __syncthreads();
    }
#undef RS_LOADKV
#undef RS_STOREKV
#undef RS_LOADQ
}
__device__ __forceinline__ void ret_scan_phase(const Params& p, int j, LAS unsigned char* lds, int seq_len, int tid, int wave, int lane, int variant) {
    const int units = (CH_ROWS / seq_len) * 64;
    if (gridDim.x == 256) {
        const int x = blockIdx.x & 7, idx = blockIdx.x >> 3;
        if (units == 128) { if (idx < 16) ret_scan(p, j, lds, seq_len, ((2 * x + (idx >> 3)) << 3) | (idx & 7), tid, wave, variant); }
        else for (int rr = 0; rr < 2; ++rr) ret_scan(p, j, lds, seq_len, ((8 * x + 4 * rr + (idx >> 3)) << 3) | (idx & 7), tid, wave, variant);
    } else
    for (int u = blockIdx.x; u < units; u += gridDim.x) ret_scan(p, j, lds, seq_len, u, tid, wave, variant);
}
__device__ __forceinline__ void ret_intra_phase(const Params& p, int j, LAS unsigned char* lds, int tid_in, int wave, int lane_in, bool dry) {
    constexpr int LDK = 264, LDVV = 288;
    const bf16_t* P = (const bf16_t*)(p.ws + WS_BIG1);
    bf16_t* Yf = (bf16_t*)(p.ws + WS_BIG2); const bf16_t* Yb = (const bf16_t*)(p.ws + WS_BIG2 + 64 * MiB);
    const float* gn = p.in[13] + j * 2048;
    LAS bf16_t* Kl = (LAS bf16_t*)lds; LAS bf16_t* Vl = Kl + 128 * LDK; LAS float* ssqp = (LAS float*)(lds + 128 * LDK * 2 + 128 * LDVV * 2);
    const int lb = wave & 1, eg = wave >> 1;
    for (int u = blockIdx.x; u < 1024; u += gridDim.x) {
        int tid = tid_in; asm volatile("" : "+v"(tid)); const int lane = tid & 63, r = lane & 31, h = lane >> 5;
        int qh = u & 1, head = (u >> 1) & 3, lc = u >> 3;
        if (gridDim.x == 256) { const int pi = (u & 255) + 256 * (u >> 9); qh = (u >> 8) & 1; head = pi & 3; lc = pi >> 2; }
        const int R0 = lc * 128;
        const float lgf = logsigmoidf_(p.in[12][j * 8 + head]), lgb = logsigmoidf_(p.in[12][j * 8 + 4 + head]);
        const int l = 64 * qh + 32 * lb + r;
        bf16x8 qf[16]; u32x4 kr[8], vr[8];
        { const bf16_t* qsrc = (const bf16_t*)(p.ws + WS_BIG1 + QT_OFF) + ((((size_t)lc * 4 + head) * 4 + (2 * qh + lb)) * 1024 + h * 32 + r) * 8;
#pragma unroll
          for (int s = 0; s < 16; ++s) qf[s] = *(const bf16x8*)(qsrc + s * 512); }
        const bf16_t* rowp = P + (size_t)(R0 + (tid >> 5)) * LDP_R + (tid & 31) * 8;
        const bool sameK = (gridDim.x == 256) && qh == 1;
        if (!sameK) {
#pragma unroll
            for (int i = 0; i < 8; ++i) kr[i] = *(const u32x4*)(rowp + (size_t)(16 * i) * LDP_R + head * 256);
        }
#pragma unroll
        for (int i = 0; i < 8; ++i) vr[i] = *(const u32x4*)(rowp + (size_t)(16 * i) * LDP_R + 1024 + head * 512);
        if (!sameK) {
#pragma unroll
            for (int i = 0; i < 8; ++i) *(LAS u32x4*)(Kl + ((tid >> 5) + 16 * i) * LDK + (tid & 31) * 8) = kr[i];
            __syncthreads();
        }
        bf16x8 wf[4][2];
#pragma unroll
        for (int kt = 0; kt < 4; ++kt) {
            f32x16 sa = {};
#pragma unroll
            for (int s = 0; s < 16; ++s) sa = mfma32(lds_rows(Kl, LDK, 32 * kt, 16 * s, lane), qf[s], sa);
#pragma unroll
            for (int i = 0; i < 16; ++i) { const int k = 32 * kt + accrow(i, h); const int diff = l - k; sa[i] *= (diff >= 0) ? __expf(lgf * (float)diff) : __expf(lgb * (float)(-diff)); }
            wf[kt][0] = pack8(sa, 0); wf[kt][1] = pack8(sa, 1);
        }
#pragma unroll
        for (int i = 0; i < 8; ++i) *(LAS u32x4*)(Vl + ((tid >> 5) + 16 * i) * LDVV + (tid & 31) * 8) = vr[i];
#pragma unroll
        for (int i = 0; i < 8; ++i) vr[i] = *(const u32x4*)(rowp + (size_t)(16 * i) * LDP_R + 1024 + head * 512 + 256);
        __syncthreads();
        f32x16 o[4] = {};
#pragma unroll
        for (int kt = 0; kt < 4; ++kt)
#pragma unroll
            for (int s2 = 0; s2 < 2; ++s2)
#pragma unroll
                for (int e2 = 0; e2 < 2; ++e2)
                    o[e2] = mfma32(lds_tr_perm(Vl, LDVV, 32 * kt + 16 * s2, eg * 64 + 32 * e2, lane), wf[kt][s2], o[e2]);
        __syncthreads();
#pragma unroll
        for (int i = 0; i < 8; ++i) *(LAS u32x4*)(Vl + ((tid >> 5) + 16 * i) * LDVV + (tid & 31) * 8) = vr[i];
        const size_t ybase = (size_t)(R0 + l) * 2048 + head * 512;
        u32x2 ya[16], yb[16];
#pragma unroll
        for (int ti = 0; ti < 4; ++ti)
#pragma unroll
            for (int g = 0; g < 4; ++g) {
                const int e = (ti >> 1) * 256 + eg * 64 + 32 * (ti & 1) + 8 * g + 4 * h;
                ya[ti * 4 + g] = *(const u32x2*)(Yf + ybase + e); yb[ti * 4 + g] = *(const u32x2*)(Yb + ybase + e);
            }
        __syncthreads();
#pragma unroll
        for (int kt = 0; kt < 4; ++kt)
#pragma unroll
            for (int s2 = 0; s2 < 2; ++s2)
#pragma unroll
                for (int e2 = 0; e2 < 2; ++e2)
                    o[2 + e2] = mfma32(lds_tr_perm(Vl, LDVV, 32 * kt + 16 * s2, eg * 64 + 32 * e2, lane), wf[kt][s2], o[2 + e2]);
        u32x2 rgv[16];
#pragma unroll
        for (int ti = 0; ti < 4; ++ti)
#pragma unroll
            for (int g = 0; g < 4; ++g) {
                const int e = (ti >> 1) * 256 + eg * 64 + 32 * (ti & 1) + 8 * g + 4 * h;
                rgv[ti * 4 + g] = *(const u32x2*)(P + (size_t)(R0 + l) * LDP_R + 3072 + head * 512 + e);
            }
        float ss = 0.f;
#pragma unroll
        for (int ti = 0; ti < 4; ++ti)
#pragma unroll
            for (int g = 0; g < 4; ++g) {
                const u32x2 a = ya[ti * 4 + g], bb = yb[ti * 4 + g];
                o[ti][4 * g + 0] += bflo(a.x) + bflo(bb.x); o[ti][4 * g + 1] += bfhi(a.x) + bfhi(bb.x); o[ti][4 * g + 2] += bflo(a.y) + bflo(bb.y); o[ti][4 * g + 3] += bfhi(a.y) + bfhi(bb.y);
                ss += (o[ti][4 * g] * o[ti][4 * g] + o[ti][4 * g + 1] * o[ti][4 * g + 1]) + (o[ti][4 * g + 2] * o[ti][4 * g + 2] + o[ti][4 * g + 3] * o[ti][4 * g + 3]);
            }
        ss += __shfl_xor(ss, 32);
        if (h == 0) ssqp[eg * 64 + 32 * lb + r] = ss;
        __syncthreads();
        const float tot = (ssqp[32 * lb + r] + ssqp[64 + 32 * lb + r]) + (ssqp[128 + 32 * lb + r] + ssqp[192 + 32 * lb + r]);
        const float rs = rsqrtf(tot * (1.0f / 512.0f) + EPS);
#pragma unroll
        for (int ti = 0; ti < 4; ++ti)
#pragma unroll
            for (int g = 0; g < 4; ++g) {
                const int e = (ti >> 1) * 256 + eg * 64 + 32 * (ti & 1) + 8 * g + 4 * h;
                const f32x4 gv = *(const f32x4*)(gn + head * 512 + e);
                const u32x2 rg = rgv[ti * 4 + g];
                const float g0 = bflo(rg.x), g1 = bfhi(rg.x), g2 = bflo(rg.y), g3 = bfhi(rg.y);
                u32x2 w; w.x = cvtpk(o[ti][4 * g] * rs * gv[0] * g0 * sigmoidf_(g0), o[ti][4 * g + 1] * rs * gv[1] * g1 * sigmoidf_(g1));
                w.y = cvtpk(o[ti][4 * g + 2] * rs * gv[2] * g2 * sigmoidf_(g2), o[ti][4 * g + 3] * rs * gv[3] * g3 * sigmoidf_(g3));
                if (!dry) *(u32x2*)(Yf + ybase + e) = w;
            }
        __syncthreads();
    }
}
__device__ __forceinline__ void act_fix_phase(const Params& p, int layer, int seq_len, int tid) {
    const bf16_t* SB = (const bf16_t*)(p.ws + WS_BIG1); bf16_t* ACT = (bf16_t*)(p.ws + WS_BIG2);
    const float* cw = p.in[16] + (size_t)layer * 3 * 2816; const float* cb = p.in[17] + (size_t)layer * 2816;
    const int gt = blockIdx.x * NTHREADS + tid, NGT = gridDim.x * NTHREADS;
    for (int it = gt; it < 512 * 352; it += NGT) {
        const int rr = it / 352, c = (it % 352) * 8;
        const int k = rr >> 1, last = rr & 1;
        const int row = 64 * k + (last ? 63 : 0);
        const int pos = row & (seq_len - 1);
        const bf16_t* sb = SB + (size_t)k * 4 * 5632 + c;
        u32x4 uv, g0, gm = {0u, 0u, 0u, 0u}, gp = {0u, 0u, 0u, 0u};
        if (last) { uv = *(const u32x4*)(sb + 1 * 5632); g0 = *(const u32x4*)(sb + 1 * 5632 + 2816); gm = *(const u32x4*)(sb + 0 * 5632 + 2816); if (pos < seq_len - 1) gp = *(const u32x4*)(sb + (4 + 2) * 5632 + 2816); }
        else { uv = *(const u32x4*)(sb + 2 * 5632); g0 = *(const u32x4*)(sb + 2 * 5632 + 2816); gp = *(const u32x4*)(sb + 3 * 5632 + 2816); if (pos > 0) gm = *(const u32x4*)(sb + (-4 + 1) * 5632 + 2816); }
        const f32x4 w0a = *(const f32x4*)(cw + c), w0b = *(const f32x4*)(cw + c + 4), w1a = *(const f32x4*)(cw + 2816 + c), w1b = *(const f32x4*)(cw + 2816 + c + 4);
        const f32x4 w2a = *(const f32x4*)(cw + 5632 + c), w2b = *(const f32x4*)(cw + 5632 + c + 4), ba = *(const f32x4*)(cb + c), bb = *(const f32x4*)(cb + c + 4);
        float y[8];
#pragma unroll
        for (int q = 0; q < 4; ++q) {
            const unsigned a = (q == 0) ? gm.x : (q == 1) ? gm.y : (q == 2) ? gm.z : gm.w;
            const unsigned bq = (q == 0) ? g0.x : (q == 1) ? g0.y : (q == 2) ? g0.z : g0.w;
            const unsigned cq = (q == 0) ? gp.x : (q == 1) ? gp.y : (q == 2) ? gp.z : gp.w;
            const unsigned uq = (q == 0) ? uv.x : (q == 1) ? uv.y : (q == 2) ? uv.z : uv.w;
            const int e0 = 2 * q, e1 = 2 * q + 1;
            const float k00 = (e0 < 4) ? w0a[e0 & 3] : w0b[e0 & 3], k10 = (e0 < 4) ? w1a[e0 & 3] : w1b[e0 & 3], k20 = (e0 < 4) ? w2a[e0 & 3] : w2b[e0 & 3], b0 = (e0 < 4) ? ba[e0 & 3] : bb[e0 & 3];
            const float k01 = (e1 < 4) ? w0a[e1 & 3] : w0b[e1 & 3], k11 = (e1 < 4) ? w1a[e1 & 3] : w1b[e1 & 3], k21 = (e1 < 4) ? w2a[e1 & 3] : w2b[e1 & 3], b1 = (e1 < 4) ? ba[e1 & 3] : bb[e1 & 3];
            const float y0 = bflo(a) * k00 + bflo(bq) * k10 + bflo(cq) * k20 + b0;
            const float y1 = bfhi(a) * k01 + bfhi(bq) * k11 + bfhi(cq) * k21 + b1;
            y[e0] = gelu_as(y0) * bflo(uq); y[e1] = gelu_as(y1) * bfhi(uq);
        }
        u32x4 w; w.x = cvtpk(y[0], y[1]); w.y = cvtpk(y[2], y[3]); w.z = cvtpk(y[4], y[5]); w.w = cvtpk(y[6], y[7]);
        *(u32x4*)(ACT + (size_t)row * 2816 + c) = w;
    }
}
typedef const __attribute__((address_space(4))) Params* KParamsPtr;
#if defined(__HIP_DEVICE_COMPILE__)
#define RELOAD_PARAMS() KParamsPtr kq_ = kp_; asm volatile("" : "+s"(kq_)); const Params p = *kq_
#else
#define RELOAD_PARAMS() const Params p = p_arg
#endif
__global__ void __launch_bounds__(NTHREADS) mega_fwd(Params p_arg) {
#if defined(__HIP_DEVICE_COMPILE__)
    const KParamsPtr kp_ = (KParamsPtr)__builtin_amdgcn_kernarg_segment_ptr();
#endif
    unsigned char* const ws_top = p_arg.ws;
    extern __shared__ __attribute__((aligned(16))) unsigned char lds_raw[];
    LAS unsigned char* lds = (LAS unsigned char*)lds_raw;
    cg::grid_group grid = cg::this_grid();
    const int tid0 = threadIdx.x;
    unsigned char* ws = ws_top;
    volatile LAS unsigned* bst = (volatile LAS unsigned*)(lds + LDS_BYTES - 64);
    if (tid0 < 16) bst[tid0] = 0u;
    __syncthreads();
    XcdBarrier bar = xcd_barrier_post((unsigned*)(ws + WS_CTL), bst);

    { RELOAD_PARAMS(); const int tid = tid0, lane = tid & 63, wave = __builtin_amdgcn_readfirstlane(tid >> 6); prologue_phase(p, lds, tid, wave, lane); chunk_start_phase(p, 0, 1, 0, wave, lane); }
    grid.sync();
    for (int chunk = 0; chunk < 3; ++chunk) {
        const int seq_len = (chunk == 0) ? 8192 : 2048;
        const size_t row0 = (size_t)chunk * CH_ROWS;
        { RELOAD_PARAMS(); int tid = tid0; asm volatile("" : "+v"(tid)); const int lane = tid & 63, wave = __builtin_amdgcn_readfirstlane(tid >> 6); if (chunk > 0) chunk_start_phase(p, chunk, 1, 1, wave, lane); }
        if (chunk > 0) xcd_barrier(bar);
        for (int layer = 0; layer < 4; ++layer) {
            const int j = layer >> 1; const bool even = (layer & 1) == 0;
            for (int step = 0; step < 8; ++step) {
                const bool isg = (step == 0 || step == 4 || step == 5 || step == 7);
                const int pbit = isg ? 1 : (step == 1 ? (even ? 0 : 4) : (step == 2 ? 0 : (step == 3 ? 0 : 8)));
                const int reps = (PROBE_MASK & pbit) ? 2 : 1;
                for (int rep = 0; rep < reps; ++rep) {
                RELOAD_PARAMS(); unsigned char* ws = p.ws;
                int tid = tid0; asm volatile("" : "+v"(tid)); const int lane = tid & 63, wave = __builtin_amdgcn_readfirstlane(tid >> 6);
                if (step == 0 || step == 4 || step == 5 || step == 7) {
                    pg8::Gemm g; EpiF E; int emode = 0;
                    E.O = (bf16_t*)(ws + WS_BIG1); E.ldo = 0; E.ssq = (const float*)(ws + WS_SSQ) + row0 * 16; E.gates = (float*)(ws + WS_GATES);
                    E.qt = (bf16_t*)(ws + WS_BIG1 + QT_OFF); E.colsub = 0; E.qn = p.in[7] + j * 64; E.kn = p.in[8] + j * 64; E.cosa = (const float*)(ws + WS_ROPE); E.sina = E.cosa + ROPE_N; E.act = (bf16_t*)(ws + WS_BIG2); E.sb = (bf16_t*)(ws + WS_BIG1); E.cw = p.in[16] + (size_t)layer * 3 * 2816; E.cb = p.in[17] + (size_t)layer * 2816; E.cosr = (const float*)(ws + WS_ROPE); E.sinr = E.cosr + ROPE_N; E.seqmask = seq_len - 1;
                    E.x = (step == 7 && layer == 3) ? p.out + row0 * DM : nullptr; E.xb = (bf16_t*)(ws + WS_XB); E.ssq_out = (float*)(ws + WS_SSQ) + row0 * 16;
                    g.M = CH_ROWS;
                    if (step == 0) {
                        g.A = (const pg8::bf16_t*)(ws + WS_XB); g.K = 1024;
                        if (even) { g.Bt = (const pg8::bf16_t*)(ws + W_ABIN + j * W_ABIN_SZ); g.N = 3072; emode = 0; E.ldo = 3072; }
                        else { g.Bt = (const pg8::bf16_t*)(ws + W_RETIN + j * W_RETIN_SZ); g.N = 6144; emode = 1; E.ldo = 5120; E.colsub = 1024; }
                    } else if (step == 4) {
                        g.A = (const pg8::bf16_t*)(ws + WS_BIG2); g.N = 1024; emode = 3;
                        if (even) { g.Bt = (const pg8::bf16_t*)(ws + W_ABOUT + j * W_ABOUT_SZ); g.K = 1024; }
                        else { g.Bt = (const pg8::bf16_t*)(ws + W_RETOUT + j * W_RETOUT_SZ); g.K = 2048; }
                    } else if (step == 5) {
                        g.A = (const pg8::bf16_t*)(ws + WS_XB); g.K = 1024; g.Bt = (const pg8::bf16_t*)(ws + W_UP + layer * W_UP_SZ); g.N = 5632; emode = 2; E.ldo = 5632;
                    } else {
                        g.A = (const pg8::bf16_t*)(ws + WS_BIG2); g.K = 2816; g.Bt = (const pg8::bf16_t*)(ws + W_DOWN + layer * W_DOWN_SZ); g.N = 1024; emode = 3;
                    }
                    pg8::StaticOrder S; S.init(g.M, g.N, (int)gridDim.x, (int)blockIdx.x);
                    if (emode == 0) { EpiT<0> ET; (EpiF&)ET = E; pg8::gemm_phase<EpiT<0>, pg8::StaticOrder, true, true>(lds, g, S, ET); }
                    else if (emode == 1) { EpiT<1> ET; (EpiF&)ET = E; pg8::gemm_phase<EpiT<1>, pg8::StaticOrder, true, true>(lds, g, S, ET); }
                    else if (emode == 2) { EpiT<2> ET; (EpiF&)ET = E; pg8::gemm_phase<EpiT<2>, pg8::StaticOrder, true, true>(lds, g, S, ET); }
                    else { EpiT<3> ET; (EpiF&)ET = E; pg8::gemm_phase<EpiT<3>, pg8::StaticOrder, true, true>(lds, g, S, ET); }
                } else if (step == 1) {
                    if (even) { mlstm_local_phase(p, j, lds, seq_len, tid, wave); if (PROBE_MASK & 2048) mlstm_local_phase(p, j, lds, seq_len, tid, wave); } else ret_scan_phase(p, j, lds, seq_len, tid, wave, lane, (rep == 0) ? 0 : PROBE_VAR);
                } else if (step == 2) {
                    if (even) mix_phase(p, j, lds, seq_len, tid, wave, lane); else { if (PROBE_MASK & 512) ret_intra_phase(p, j, lds, tid, wave, lane, true); ret_intra_phase(p, j, lds, tid, wave, lane, false); }
                } else if (step == 3) {
                    if (even) { mlstm_out_phase(p, j, lds, seq_len, tid, wave); if (PROBE_MASK & 256) mlstm_out_phase(p, j, lds, seq_len, tid, wave); xcd_barrier(bar); fin_ab_phase(p, j, wave, lane); if (PROBE_MASK & 1024) fin_ab_phase(p, j, wave, lane); } else break;
                } else {
                    act_fix_phase(p, layer, seq_len, tid);
                }
                xcd_barrier(bar);
                if (PROBE_MASK & 32) xcd_barrier(bar);
                }
            }
        }
    }
    { RELOAD_PARAMS(); int tid = tid0; asm volatile("" : "+v"(tid)); const int lane = tid & 63, wave = __builtin_amdgcn_readfirstlane(tid >> 6); chunk_start_phase(p, 2, 0, 1, wave, lane); }
}

extern "C" void kernel_launch(void* const* d_in, const int* in_sizes, int n_in, void* d_out, int out_size, void* d_ws, size_t ws_size, hipStream_t stream) {
    static int grid = 0;
    if (grid == 0) {
        if (n_in != 19 || out_size != TOT_ROWS * DM || ws_size < WS_CTL + CTL_BYTES) { fprintf(stderr, "kernel_launch: unexpected shapes / workspace (%d inputs, out %d, ws %zu)\n", n_in, out_size, ws_size); grid = -1; return; }
        int dev = 0, cus = 0, per_cu = 0;
        hipGetDevice(&dev); hipDeviceGetAttribute(&cus, hipDeviceAttributeMultiprocessorCount, dev);
        if (hipFuncSetAttribute((const void*)mega_fwd, hipFuncAttributeMaxDynamicSharedMemorySize, LDS_BYTES) != hipSuccess) { fprintf(stderr, "kernel_launch: hipFuncSetAttribute failed\n"); grid = -1; return; }
        hipOccupancyMaxActiveBlocksPerMultiprocessor(&per_cu, (const void*)mega_fwd, NTHREADS, LDS_BYTES);
        (void)hipGetLastError();
        if (per_cu < 1) per_cu = 1;
        grid = cus;
        if (grid > 256) grid = 256;
    }
    if (grid < 0) return;
    Params p{};
    for (int i = 0; i < 19; ++i) p.in[i] = (const float*)d_in[i];
    p.out = (float*)d_out; p.ws = (unsigned char*)d_ws;
    void* args[] = {&p};
    if (hipMemsetAsync((char*)d_ws + WS_CTL, 0, CTL_BYTES, stream) != hipSuccess) { fprintf(stderr, "kernel_launch: memset failed\n"); return; }
    hipError_t e = hipLaunchCooperativeKernel((const void*)mega_fwd, dim3(grid), dim3(NTHREADS), args, LDS_BYTES, stream);
    if (e != hipSuccess) fprintf(stderr, "cooperative launch failed: %s (grid %d)\n", hipGetErrorString(e), grid);
}
```

```cpp
#include <hip/hip_runtime.h>
#include <hip/hip_cooperative_groups.h>
#include <cstdio>
#include <cstdint>
namespace cg = cooperative_groups;
#ifndef PROBE_MASK
#define PROBE_MASK 0
#endif
#ifndef PROBE_VAR
#define PROBE_VAR 0
#endif
namespace pg8 {
#define PG8_LAS __attribute__((address_space(3)))
typedef unsigned short bf16_t;
typedef short bf16x8 __attribute__((ext_vector_type(8)));
typedef float f32x4 __attribute__((ext_vector_type(4)));
typedef unsigned u32x4 __attribute__((ext_vector_type(4)));
constexpr int BM = 256, BK = 64, HALF = 128, HTB = HALF * BK * 2  , STAGE_BYTES = 8 * HTB, NXCD = 8, WGM = 2;

__host__ __device__ __forceinline__ int lds_byte(int r, int c) { const int st = (r >> 4) * 2 + (c >> 5), rr = r & 15, cc = c & 31, ob = rr * 64 + cc * 2; return st * 1024 + (ob ^ (((ob >> 9) & 1) << 5)); }
__host__ __device__ __forceinline__ void stage_rc(int b, int& R, int& C) { const int st = b / 1024, sb = b % 1024, swz = sb ^ (((sb >> 9) & 1) << 5); R = (st >> 1) * 16 + swz / 64; C = (st & 1) * 32 + (swz % 64) / 2; }
__host__ __device__ __forceinline__ int perm32(int rho) { const int n = rho >> 4, i = rho & 15; return 8 * (i >> 2) + 4 * n + (i & 3); }

struct Unit { int pm, pn; };
struct Gemm { const bf16_t* A; const bf16_t* Bt; int M, N, K; };

struct StaticOrder {
    int nM, nN, nwg, G, c;
    __host__ __device__ void init(int M, int N, int G_, int c_) { nM = M / BM; nN = N / BM; nwg = nM * nN; G = G_; c = c_; }
    __host__ __device__ bool next(int i, Unit& u) const {
        const long L = (long)i * G + c; if (L >= nwg) return false;
        int wgid = (int)L; { const int q = nwg / NXCD, r = nwg % NXCD, xcd = wgid % NXCD, off = wgid / NXCD; wgid = (xcd < r ? xcd * (q + 1) : r * (q + 1) + (xcd - r) * q) + off; }
        const int nig = WGM * nN, gid = wgid / nig, fm = gid * WGM, gsz = (nM - fm) < WGM ? (nM - fm) : WGM;
        u.pm = fm + ((wgid % nig) % gsz); u.pn = (wgid % nig) / gsz; return true;
    }
    __device__ __forceinline__ void a_ready(const Unit&) const {}
    __device__ __forceinline__ void done(const Unit&) const {}
};

template <class Epi, class Sched, bool ALIGN_EPI = false, bool SP2 = false>
__device__ __forceinline__ void gemm_phase(PG8_LAS unsigned char* lds, const Gemm g, const Sched& S, const Epi& E) {
    int tid_o = threadIdx.x; asm volatile("" : "+v"(tid_o)); const int tid = tid_o, wid = __builtin_amdgcn_readfirstlane(tid >> 6), lane = tid & 63, wr = wid >> 2, wc = wid & 3, fr = lane & 15, fq = lane >> 4;
    const int K = g.K, nt = K / BK;
    unsigned voffA[2], voffB[2];
#pragma unroll
    for (int i = 0; i < 2; ++i) { int R, C; stage_rc(tid * 16 + i * 8192, R, C); const int Rb = Epi::PERM ? ((R & ~31) + perm32(R & 31)) : R;
        voffA[i] = (unsigned)(R * K + C) * 2u; voffB[i] = (unsigned)(Rb * K + C) * 2u; }
    const size_t kstep = (size_t)(BK * 2);
    const size_t hstep = (size_t)HALF * K * 2;
    const size_t tstep = 2 * hstep;
    const unsigned ldsw = (unsigned)wid * 1024u;
    const int aoff = lds_byte(wr * 64 + fr, fq * 8), boff = lds_byte(wc * 32 + fr, fq * 8);
#define PG8_SA(b, h) (((b) * 2 + (h)) * HTB)
#define PG8_SB(b, h) ((4 + (b) * 2 + (h)) * HTB)
#define PG8_STAGE(bufoff, gbase, voff) do { _Pragma("unroll") for (int _i = 0; _i < 2; ++_i) \
        __builtin_amdgcn_global_load_lds((const unsigned*)((const char*)(gbase) + (voff)[_i]), (PG8_LAS unsigned*)(lds + (bufoff) + ldsw + _i * 8192), 16, 0, 0); } while (0)
#define PG8_LDA(dst, b, h) do { _Pragma("unroll") for (int m = 0; m < 4; ++m) _Pragma("unroll") for (int k = 0; k < 2; ++k) dst[m][k] = *(const PG8_LAS bf16x8*)(lds + PG8_SA(b, h) + aoff + m * 2048 + k * 1024); } while (0)
#define PG8_LDB(dst, b, h) do { _Pragma("unroll") for (int n = 0; n < 2; ++n) _Pragma("unroll") for (int k = 0; k < 2; ++k) dst[n][k] = *(const PG8_LAS bf16x8*)(lds + PG8_SB(b, h) + boff + n * 2048 + k * 1024); } while (0)
#define PG8_MMA(ai, bj, At, Bt) do { __builtin_amdgcn_s_setprio(1); _Pragma("unroll") for (int m = 0; m < 4; ++m) _Pragma("unroll") for (int n = 0; n < 2; ++n) _Pragma("unroll") for (int k = 0; k < 2; ++k) \
        acc[ai][bj][m][n] = __builtin_amdgcn_mfma_f32_16x16x32_bf16(Bt[n][k], At[m][k], acc[ai][bj][m][n], 0, 0, 0); __builtin_amdgcn_s_setprio(0); } while (0)
#define PG8_WAIT_V(n) asm volatile("s_waitcnt vmcnt(" #n ")" ::: "memory")
#define PG8_WAIT_L(n) asm volatile("s_waitcnt lgkmcnt(" #n ")" ::: "memory")
#define PG8_BAR __builtin_amdgcn_s_barrier()
#define PG8_SCHED __builtin_amdgcn_sched_barrier(0)
    Unit cur, nxt; int ui = 0;
    if (!S.next(0, cur)) return;
    f32x4 acc[2][2][4][2];
    E.init(acc, cur, wr, wc, fr, fq);
    bf16x8 At[4][2], B0[2][2], B1[2][2];
    const char* cA = (const char*)g.A + (size_t)cur.pm * tstep; const char* cB = (const char*)g.Bt + (size_t)cur.pn * tstep;
    S.a_ready(cur);
    if constexpr (SP2) {
        PG8_STAGE(PG8_SB(0, 0), cB, voffB); PG8_STAGE(PG8_SB(0, 1), cB + hstep, voffB); PG8_STAGE(PG8_SA(0, 0), cA, voffA); PG8_STAGE(PG8_SA(0, 1), cA + hstep, voffA);
        if (wr == 1) PG8_BAR;
        PG8_WAIT_V(2); PG8_BAR;
        PG8_STAGE(PG8_SB(1, 0), cB + kstep, voffB); PG8_STAGE(PG8_SA(1, 0), cA + kstep, voffA); PG8_STAGE(PG8_SB(1, 1), cB + hstep + kstep, voffB);
        PG8_WAIT_V(6); PG8_BAR;
    } else {
        PG8_STAGE(PG8_SB(0, 0), cB, voffB); PG8_STAGE(PG8_SA(0, 0), cA, voffA); PG8_STAGE(PG8_SB(0, 1), cB + hstep, voffB); PG8_STAGE(PG8_SA(0, 1), cA + hstep, voffA);
        if (wr == 1) PG8_BAR;
        PG8_WAIT_V(4); PG8_BAR;
        PG8_STAGE(PG8_SB(1, 0), cB + kstep, voffB); PG8_STAGE(PG8_SA(1, 0), cA + kstep, voffA); PG8_STAGE(PG8_SB(1, 1), cB + hstep + kstep, voffB);
        PG8_WAIT_V(6); PG8_BAR;
    }
    for (;;) {
        const bool has_next = S.next(ui + 1, nxt);
        const char* nA = has_next ? (const char*)g.A + (size_t)nxt.pm * tstep : cA; const char* nB = has_next ? (const char*)g.Bt + (size_t)nxt.pn * tstep : cB;
        for (int t = 0; t < nt; t += 2) {
            const bool last = (t == nt - 2);
            const char* a1 = cA + (size_t)(t + 1) * kstep;
            const char* a2 = last ? nA : cA + (size_t)(t + 2) * kstep; const char* b2 = last ? nB : cB + (size_t)(t + 2) * kstep;
            const char* a3 = a2 + kstep; const char* b3 = b2 + kstep;
            if (last && has_next) S.a_ready(nxt);
            if constexpr (SP2) {
            PG8_LDB(B0, 0, 0); PG8_LDB(B1, 0, 1); PG8_SCHED; PG8_LDA(At, 0, 0); PG8_STAGE(PG8_SA(1, 1), a1 + hstep, voffA);
            PG8_WAIT_V(8); PG8_WAIT_L(0); PG8_BAR; PG8_MMA(0, 0, At, B0); PG8_MMA(0, 1, At, B1); PG8_BAR; PG8_SCHED;
            PG8_LDA(At, 0, 1); PG8_STAGE(PG8_SB(0, 0), b2, voffB); PG8_STAGE(PG8_SB(0, 1), b2 + hstep, voffB); PG8_STAGE(PG8_SA(0, 0), a2, voffA);
            PG8_WAIT_V(8); PG8_WAIT_L(0); PG8_BAR; PG8_MMA(1, 0, At, B0); PG8_MMA(1, 1, At, B1); PG8_BAR; PG8_SCHED;
            PG8_LDB(B0, 1, 0); PG8_LDB(B1, 1, 1); PG8_SCHED; PG8_LDA(At, 1, 0); PG8_STAGE(PG8_SA(0, 1), a2 + hstep, voffA);
            PG8_WAIT_V(8); PG8_WAIT_L(0); PG8_BAR; PG8_MMA(0, 0, At, B0); PG8_MMA(0, 1, At, B1); PG8_BAR; PG8_SCHED;
            PG8_LDA(At, 1, 1); PG8_STAGE(PG8_SB(1, 0), b3, voffB); PG8_STAGE(PG8_SB(1, 1), b3 + hstep, voffB); PG8_STAGE(PG8_SA(1, 0), a3, voffA);
            PG8_WAIT_V(8); PG8_WAIT_L(0); PG8_BAR; PG8_MMA(1, 0, At, B0); PG8_MMA(1, 1, At, B1); PG8_BAR; PG8_SCHED;
            } else {
            PG8_LDB(B0, 0, 0); PG8_SCHED; PG8_LDA(At, 0, 0); PG8_STAGE(PG8_SA(1, 1), a1 + hstep, voffA);
            PG8_WAIT_L(8); PG8_BAR; PG8_WAIT_L(0); PG8_MMA(0, 0, At, B0); PG8_BAR; PG8_SCHED;
            PG8_LDB(B1, 0, 1); PG8_STAGE(PG8_SB(0, 0), b2, voffB);
            PG8_BAR; PG8_WAIT_L(0); PG8_MMA(0, 1, At, B1); PG8_BAR;
            PG8_LDA(At, 0, 1); PG8_STAGE(PG8_SA(0, 0), a2, voffA);
            PG8_BAR; PG8_WAIT_L(0); PG8_MMA(1, 0, At, B0); PG8_BAR; PG8_SCHED;
            PG8_STAGE(PG8_SB(0, 1), b2 + hstep, voffB);
            PG8_WAIT_V(6); PG8_BAR; PG8_MMA(1, 1, At, B1); PG8_BAR;
            PG8_LDB(B0, 1, 0); PG8_SCHED; PG8_LDA(At, 1, 0); PG8_STAGE(PG8_SA(0, 1), a2 + hstep, voffA);
            PG8_WAIT_L(8); PG8_BAR; PG8_WAIT_L(0); PG8_MMA(0, 0, At, B0); PG8_BAR; PG8_SCHED;
            PG8_LDB(B1, 1, 1); PG8_STAGE(PG8_SB(1, 0), b3, voffB);
            PG8_BAR; PG8_WAIT_L(0); PG8_MMA(0, 1, At, B1); PG8_BAR;
            PG8_LDA(At, 1, 1); PG8_STAGE(PG8_SA(1, 0), a3, voffA);
            PG8_BAR; PG8_WAIT_L(0); PG8_MMA(1, 0, At, B0); PG8_BAR; PG8_SCHED;
            PG8_STAGE(PG8_SB(1, 1), b3 + hstep, voffB);
            PG8_WAIT_V(6); PG8_BAR; PG8_MMA(1, 1, At, B1); PG8_BAR;
            }
        }
        if constexpr (ALIGN_EPI) { if (wr == 0) PG8_BAR; }
        if constexpr (!Epi::AFTER_DRAIN) { E(acc, cur, wr, wc, fr, fq); S.done(cur); }
        if (!has_next) break;
        E.init(acc, nxt, wr, wc, fr, fq);
        cur = nxt; cA = nA; cB = nB; ++ui;
        if constexpr (ALIGN_EPI) { if (wr == 1) PG8_BAR; }
    }
    PG8_WAIT_V(0);
    if constexpr (!ALIGN_EPI) { if (wr == 0) PG8_BAR; }
    PG8_BAR;
    if constexpr (Epi::AFTER_DRAIN) { E.fused(acc, cur, wr, wc, fr, fq, lds, wid, lane); S.done(cur); }
#undef PG8_SA
#undef PG8_SB
#undef PG8_STAGE
#undef PG8_LDA
#undef PG8_LDB
#undef PG8_MMA
#undef PG8_WAIT_V
#undef PG8_WAIT_L
#undef PG8_BAR
#undef PG8_SCHED
}
}
#define LAS __attribute__((address_space(3)))
typedef unsigned short bf16_t;
typedef short bf16x8 __attribute__((ext_vector_type(8)));
typedef short s16x4 __attribute__((ext_vector_type(4)));
typedef float f32x4 __attribute__((ext_vector_type(4)));
typedef float f32x16 __attribute__((ext_vector_type(16)));
typedef unsigned u32x4 __attribute__((ext_vector_type(4)));
typedef unsigned u32x2 __attribute__((ext_vector_type(2)));
typedef float f32x2_t __attribute__((ext_vector_type(2)));
typedef __bf16 bf16x2_t __attribute__((ext_vector_type(2)));

constexpr int NTHREADS = 512;
constexpr int LDS_BYTES = 147456;
constexpr int DM = 1024;
constexpr int CH_ROWS = 16384;
constexpr int TOT_ROWS = 49152;
constexpr float EPS = 1e-6f;
constexpr float LOG2E = 1.4426950408889634f;

constexpr size_t MiB = 1u << 20;
constexpr size_t W_ABIN = 0, W_ABIN_SZ = (size_t)3072 * 1024 * 2;
constexpr size_t W_ABOUT = W_ABIN + 2 * W_ABIN_SZ, W_ABOUT_SZ = (size_t)1024 * 1024 * 2;
constexpr size_t W_RETIN = W_ABOUT + 2 * W_ABOUT_SZ, W_RETIN_SZ = (size_t)6144 * 1024 * 2;
constexpr size_t W_RETOUT = W_RETIN + 2 * W_RETIN_SZ, W_RETOUT_SZ = (size_t)1024 * 2048 * 2;
constexpr size_t W_UP = W_RETOUT + 2 * W_RETOUT_SZ, W_UP_SZ = (size_t)5632 * 1024 * 2;
constexpr size_t W_DOWN = W_UP + 4 * W_UP_SZ, W_DOWN_SZ = (size_t)1024 * 2816 * 2;
static_assert(W_DOWN + 4 * W_DOWN_SZ <= 120 * MiB, "weights");
constexpr size_t WS_XB = 120 * MiB;
constexpr size_t WS_BIG1 = 152 * MiB;
constexpr size_t WS_BIG2 = 344 * MiB;
constexpr size_t WS_SSQ = 472 * MiB;
constexpr size_t WS_GATES = 475 * MiB;
constexpr size_t WS_ROPE = 476 * MiB;
constexpr size_t WS_END = 486 * MiB;
constexpr int RA_ROW = 0, RA_COL = 128 * 16, RR_ROW = RA_COL + 64 * 16, RR_COL = RR_ROW + 128 * 64, ROPE_N = RR_COL + 64 * 64;
constexpr size_t WS_CTL = 486 * MiB, CTL_BYTES = 65536;

struct Params { const float* in[19]; float* out; unsigned char* ws; };

__device__ __forceinline__ unsigned cvtpk(float lo, float hi) { f32x2_t v = {lo, hi}; bf16x2_t b = __builtin_convertvector(v, bf16x2_t); return __builtin_bit_cast(unsigned, b); }
__device__ __forceinline__ bf16_t f2bf(float f) { return (bf16_t)(cvtpk(f, 0.f) & 0xffffu); }
__device__ __forceinline__ float bf2f(bf16_t b) { return __uint_as_float((unsigned)b << 16); }
__device__ __forceinline__ float bflo(unsigned u) { return __uint_as_float(u << 16); }
__device__ __forceinline__ float bfhi(unsigned u) { return __uint_as_float(u & 0xffff0000u); }
__device__ __forceinline__ float wave_sum(float v) {
#pragma unroll
    for (int o = 1; o < 64; o <<= 1) v += __shfl_xor(v, o);
    return v;
}
__device__ __forceinline__ float sigmoidf_(float x) { return 1.f / (1.f + __expf(-x)); }
__device__ __forceinline__ float logsigmoidf_(float x) { return fminf(x, 0.f) - log1pf(__expf(-fabsf(x))); }

__device__ __forceinline__ bf16x8 lds_rows(const LAS bf16_t* base, int ld, int row0, int k0, int lane) {
    return *(const LAS bf16x8*)(base + (row0 + (lane & 31)) * ld + k0 + 8 * (lane >> 5));
}
__device__ __forceinline__ s16x4 tr16(const LAS bf16_t* p) {
    return __builtin_bit_cast(s16x4, __builtin_amdgcn_ds_read_tr16_b64_v4i16((LAS s16x4*)p));
}
__device__ __forceinline__ bf16x8 lds_tr(const LAS bf16_t* base, int ld, int k0, int c0, int lane) {
#ifdef SLOW_TR
    bf16x8 o;
#pragma unroll
    for (int j = 0; j < 8; ++j) o[j] = (short)base[(k0 + 8 * (lane >> 5) + j) * ld + c0 + (lane & 31)];
    return o;
#else
    const int g = lane >> 4, i = lane & 15, q = i >> 2, p = i & 3, h = g >> 1;
    const LAS bf16_t* a = base + (k0 + 8 * h + q) * ld + c0 + 16 * (g & 1) + 4 * p;
    const s16x4 lo = tr16(a), hi = tr16(a + 4 * ld);
    return (bf16x8){lo[0], lo[1], lo[2], lo[3], hi[0], hi[1], hi[2], hi[3]};
#endif
}
__device__ __forceinline__ bf16x8 lds_tr_perm(const LAS bf16_t* base, int ld, int k0, int c0, int lane) {
#ifdef SLOW_TR
    bf16x8 o;
#pragma unroll
    for (int j = 0; j < 8; ++j) o[j] = (short)base[(k0 + 8 * (j >> 2) + 4 * (lane >> 5) + (j & 3)) * ld + c0 + (lane & 31)];
    return o;
#else
    const int g = lane >> 4, i = lane & 15, q = i >> 2, p = i & 3, h = g >> 1;
    const LAS bf16_t* a = base + (k0 + 4 * h + q) * ld + c0 + 16 * (g & 1) + 4 * p;
    const s16x4 lo = tr16(a), hi = tr16(a + 8 * ld);
    return (bf16x8){lo[0], lo[1], lo[2], lo[3], hi[0], hi[1], hi[2], hi[3]};
#endif
}
__device__ __forceinline__ f32x16 mfma32(bf16x8 a, bf16x8 b, f32x16 c) { return __builtin_amdgcn_mfma_f32_32x32x16_bf16(a, b, c, 0, 0, 0); }
__device__ __forceinline__ bf16x8 pack8(const f32x16& a, int s) {
    u32x4 w; w.x = cvtpk(a[8 * s + 0], a[8 * s + 1]); w.y = cvtpk(a[8 * s + 2], a[8 * s + 3]); w.z = cvtpk(a[8 * s + 4], a[8 * s + 5]); w.w = cvtpk(a[8 * s + 6], a[8 * s + 7]);
    return __builtin_bit_cast(bf16x8, w);
}
__device__ __forceinline__ int accrow(int reg, int h) { return (reg & 3) + 8 * (reg >> 2) + 4 * h; }
__device__ __forceinline__ float gelu_as(float v) {
    const float av = fabsf(v), t = __builtin_amdgcn_rcpf(av * 0.2316418882f + 1.0f);
    float q = t * 0.5307027145f + (-0.7265760135f); q = q * t + 0.7107068705f; q = q * t + (-0.142248368f); q = q * t + 0.127414796f; q = q * t;
    const float e = __builtin_amdgcn_exp2f((v * v) * (-0.72134752044f));
    const float m = v * (q * e);
    return v < 0.f ? m : v - m;
}
#define XB_TMO      128
#define XB_XCNT(j)  (256  + 64 * (j))
#define XB_XSUB(j)  (1280 + 64 * (j))
#define XB_XGEN(j)  (2304 + 64 * (j))
#define XB_TOP      3328
#define XB_TOPGEN   3392
#define XCD_BAR_WORDS 3456
#define XB_SPIN_CAP (1u << 18)

__device__ __forceinline__ unsigned xb_ld(unsigned* p)              { return __hip_atomic_load(p, __ATOMIC_RELAXED, __HIP_MEMORY_SCOPE_AGENT); }
__device__ __forceinline__ unsigned xb_add(unsigned* p, unsigned v) { return __hip_atomic_fetch_add(p, v, __ATOMIC_RELAXED, __HIP_MEMORY_SCOPE_AGENT); }
__device__ __forceinline__ unsigned xb_xcc_id() { return (unsigned)__builtin_amdgcn_s_getreg((3 << 11) | 20) & 0xFu; }
#define XB_SPIN(cond, bar) do { unsigned _sp = 0; while (cond) { __builtin_amdgcn_s_sleep(1); \
    if ((++_sp & 255u) == 0u) { if (xb_ld(&(bar)[XB_TMO])) break; if (_sp > XB_SPIN_CAP) { atomicAdd(&(bar)[XB_TMO], 1u); break; } } } } while (0)

struct XcdBarrier {
    unsigned* bar; unsigned x;
    volatile LAS unsigned* st;
};

__device__ __forceinline__ XcdBarrier xcd_barrier_post(unsigned* bar, volatile LAS unsigned* st) {
    XcdBarrier b; b.bar = bar; b.x = xb_xcc_id(); b.st = st;
    if (threadIdx.x == 0) (void)xb_add(&bar[XB_XCNT(b.x)], 1u);
    return b;
}
__device__ __forceinline__ void xcd_barrier_complete(unsigned* bar, unsigned x, unsigned& nloc, unsigned& nx) {
    const unsigned G = gridDim.x * gridDim.y * gridDim.z;
    unsigned sum, cnt, mine, sp = 0u;
    for (;;) {
        sum = 0u; cnt = 0u; mine = 0u;
#pragma unroll
        for (unsigned j = 0; j < 16; ++j) { const unsigned c = xb_ld(&bar[XB_XCNT(j)]); sum += c; cnt += (c > 0u) ? 1u : 0u; mine = (j == x) ? c : mine; }
        if (sum == G) break;
        __builtin_amdgcn_s_sleep(1);
        if ((++sp & 255u) == 0u) { if (xb_ld(&bar[XB_TMO])) break; if (sp > XB_SPIN_CAP) { atomicAdd(&bar[XB_TMO], 1u); break; } }
    }
    nloc = mine > 0u ? mine : 1u; nx = cnt > 0u ? cnt : 1u;
}

__device__ __forceinline__ void xcd_barrier(const XcdBarrier& b) {
    asm volatile("s_waitcnt vmcnt(0)" ::: "memory");
    __syncthreads();
    if (threadIdx.x == 0) {
        unsigned* bar = b.bar;
        __builtin_amdgcn_s_waitcnt(0);
        unsigned nloc = b.st[0], nx = b.st[1];
        if (nloc == 0u) { xcd_barrier_complete(bar, b.x, nloc, nx); b.st[0] = nloc; b.st[1] = nx; }
        const unsigned old = xb_add(&bar[XB_XSUB(b.x)], 1u);
        const unsigned gen = old / nloc;
        if (old + 1u == (gen + 1u) * nloc) {
            __builtin_amdgcn_fence(__ATOMIC_RELEASE, "agent");
            asm volatile("s_waitcnt vmcnt(0)" ::: "memory");
            const unsigned og = xb_add(&bar[XB_TOP], 1u);
            const unsigned tg = og / nx;
            if (og + 1u == (tg + 1u) * nx) xb_add(&bar[XB_TOPGEN], 1u);
            else XB_SPIN(xb_ld(&bar[XB_TOPGEN]) == tg, bar);
            __builtin_amdgcn_fence(__ATOMIC_ACQUIRE, "agent");
            xb_add(&bar[XB_XGEN(b.x)], 1u);
            asm volatile("s_waitcnt vmcnt(0)" ::: "memory");
        } else {
            XB_SPIN(xb_ld(&bar[XB_XGEN(b.x)]) == gen, bar);
            __builtin_amdgcn_fence(__ATOMIC_ACQUIRE, "agent");
            asm volatile("s_waitcnt vmcnt(0)" ::: "memory");
        }
    }
    __syncthreads();
}
struct EpiF {
    bf16_t* O; int ldo;
    const float* ssq;
    float* gates;
    bf16_t* qt; int colsub;
    bf16_t* act; bf16_t* sb; const float* cw; const float* cb;
    const float* qn; const float* kn; const float* cosa; const float* sina;
    const float* cosr; const float* sinr; int seqmask;
    float* x; bf16_t* xb; float* ssq_out;
};
template <int MODE  > struct EpiT : EpiF {
    static constexpr bool PERM = true, AFTER_DRAIN = false;
    static constexpr int mode = MODE;
    __device__ __forceinline__ void init(pg8::f32x4 (&acc)[2][2][4][2], const pg8::Unit& u, int wr, int wc, int fr, int fq) const {
        if (false) {
            const int rowb = u.pm * 256 + wr * 64 + fr, colb = u.pn * 256 + wc * 32 + 8 * fq;
#pragma unroll
            for (int ai = 0; ai < 2; ++ai)
#pragma unroll
                for (int m = 0; m < 4; ++m) {
                    const float* xr = x + (size_t)(rowb + ai * 128 + m * 16) * DM + colb;
#pragma unroll
                    for (int bj = 0; bj < 2; ++bj) { acc[ai][bj][m][0] = *(const f32x4*)(xr + bj * 128); acc[ai][bj][m][1] = *(const f32x4*)(xr + bj * 128 + 4); }
                }
        } else {
#pragma unroll
            for (int ai = 0; ai < 2; ++ai)
#pragma unroll
                for (int bj = 0; bj < 2; ++bj)
#pragma unroll
                    for (int m = 0; m < 4; ++m) { acc[ai][bj][m][0] = (f32x4){0.f, 0.f, 0.f, 0.f}; acc[ai][bj][m][1] = (f32x4){0.f, 0.f, 0.f, 0.f}; }
        }
    }
    __device__ __forceinline__ void operator()(const pg8::f32x4 (&acc)[2][2][4][2], const pg8::Unit& u, int wr, int wc, int fr, int fq) const {
        const int rowb = u.pm * 256 + wr * 64 + fr;
        const int colb = u.pn * 256 + wc * 32 + 8 * fq;
        if (mode == 3) {
#pragma unroll
            for (int ai = 0; ai < 2; ++ai)
#pragma unroll
                for (int m = 0; m < 4; ++m) {
                    const int row = rowb + ai * 128 + m * 16;
                    bf16_t* xbr = xb + (size_t)row * DM + colb;
                    float ss = 0.f;
#pragma unroll
                    for (int bj = 0; bj < 2; ++bj) {
                        const u32x4 xo = *(const u32x4*)(xbr + bj * 128);
                        f32x4 v0 = acc[ai][bj][m][0], v1 = acc[ai][bj][m][1];
                        v0[0] += bflo(xo.x); v0[1] += bfhi(xo.x); v0[2] += bflo(xo.y); v0[3] += bfhi(xo.y);
                        v1[0] += bflo(xo.z); v1[1] += bfhi(xo.z); v1[2] += bflo(xo.w); v1[3] += bfhi(xo.w);
                        if (x) {
                            float* xr = x + (size_t)row * DM + colb + bj * 128;
                            *(f32x4*)xr = v0; *(f32x4*)(xr + 4) = v1;
                        } else {
                            u32x4 w; w.x = cvtpk(v0[0], v0[1]); w.y = cvtpk(v0[2], v0[3]); w.z = cvtpk(v1[0], v1[1]); w.w = cvtpk(v1[2], v1[3]);
                            *(u32x4*)(xbr + bj * 128) = w;
                            v0[0] = bflo(w.x); v0[1] = bfhi(w.x); v0[2] = bflo(w.y); v0[3] = bfhi(w.y); v1[0] = bflo(w.z); v1[1] = bfhi(w.z); v1[2] = bflo(w.w); v1[3] = bfhi(w.w);
                        }
                        ss += (v0[0] * v0[0] + v0[1] * v0[1]) + (v0[2] * v0[2] + v0[3] * v0[3]) + (v1[0] * v1[0] + v1[1] * v1[1]) + (v1[2] * v1[2] + v1[3] * v1[3]);
                    }
                    ss += __shfl_xor(ss, 16); ss += __shfl_xor(ss, 32);
                    if (fq == 0) ssq_out[(size_t)row * 16 + u.pn * 4 + wc] = ss;
                }
            return;
        }
        if (mode == 2) {
            const int lane16 = fr;
            const int ch0 = u.pn * 128 + wc * 32 + 8 * fq;
            f32x4 kw0[2], kw1[2], kw2[2], kb[2];
#pragma unroll
            for (int n = 0; n < 2; ++n) { kw0[n] = *(const f32x4*)(cw + ch0 + 4 * n); kw1[n] = *(const f32x4*)(cw + 2816 + ch0 + 4 * n); kw2[n] = *(const f32x4*)(cw + 5632 + ch0 + 4 * n); kb[n] = *(const f32x4*)(cb + ch0 + 4 * n); }
            float rsa[2][4];
            {
                f32x4 sv[2][4];
#pragma unroll
                for (int ai = 0; ai < 2; ++ai)
#pragma unroll
                    for (int m = 0; m < 4; ++m) sv[ai][m] = *(const f32x4*)(ssq + (size_t)(rowb + ai * 128 + m * 16) * 16 + 4 * fq);
#pragma unroll
                for (int ai = 0; ai < 2; ++ai)
#pragma unroll
                    for (int m = 0; m < 4; ++m) {
                        float ss = (sv[ai][m][0] + sv[ai][m][1]) + (sv[ai][m][2] + sv[ai][m][3]);
                        ss += __shfl_xor(ss, 16); ss += __shfl_xor(ss, 32);
                        rsa[ai][m] = rsqrtf(ss * (1.0f / DM) + EPS);
                    }
            }
#pragma unroll
            for (int ai = 0; ai < 2; ++ai) {
                float rs[4];
#pragma unroll
                for (int m = 0; m < 4; ++m) rs[m] = rsa[ai][m];
#pragma unroll
                for (int m = 0; m < 4; ++m) {
                    const int row = rowb + ai * 128 + m * 16;
                    const int mp = (m > 0) ? m - 1 : 0, mn = (m < 3) ? m + 1 : 3;
                    u32x4 wo, wu, wg; unsigned wv[4], uvv[4], gvv[4];
#pragma unroll
                    for (int n = 0; n < 2; ++n) {
                        const f32x4 us = acc[ai][0][m][n] * rs[m];
                        float y[4];
#pragma unroll
                        for (int jj = 0; jj < 4; ++jj) {
                            const float gc = acc[ai][1][m][n][jj] * rs[m];
                            const float tp = (lane16 == 15) ? acc[ai][1][mp][n][jj] * rs[mp] : gc, tn = (lane16 == 0) ? acc[ai][1][mn][n][jj] * rs[mn] : gc;
                            const float gprev = __int_as_float(__builtin_amdgcn_update_dpp(0, __float_as_int(tp), 0x121, 0xf, 0xf, false));
                            const float gnext = __int_as_float(__builtin_amdgcn_update_dpp(0, __float_as_int(tn), 0x12f, 0xf, 0xf, false));
                            const float yy = gprev * kw0[n][jj] + gc * kw1[n][jj] + gnext * kw2[n][jj] + kb[n][jj];
                            y[jj] = gelu_as(yy) * us[jj];
                        }
                        wv[2 * n] = cvtpk(y[0], y[1]); wv[2 * n + 1] = cvtpk(y[2], y[3]);
                        uvv[2 * n] = cvtpk(us[0], us[1]); uvv[2 * n + 1] = cvtpk(us[2], us[3]);
                        { const f32x4 gq = acc[ai][1][m][n] * rs[m]; gvv[2 * n] = cvtpk(gq[0], gq[1]); gvv[2 * n + 1] = cvtpk(gq[2], gq[3]); }
                    }
                    wo.x = wv[0]; wo.y = wv[1]; wo.z = wv[2]; wo.w = wv[3];
                    *(u32x4*)(act + (size_t)row * 2816 + ch0) = wo;
                    const int r64 = (m * 16 + lane16);
                    if (r64 < 2 || r64 >= 62) {
                        wu.x = uvv[0]; wu.y = uvv[1]; wu.z = uvv[2]; wu.w = uvv[3]; wg.x = gvv[0]; wg.y = gvv[1]; wg.z = gvv[2]; wg.w = gvv[3];
                        bf16_t* sbr = sb + ((size_t)(row >> 6) * 4 + ((r64 < 2) ? r64 + 2 : r64 - 62)) * 5632 + ch0;
                        *(u32x4*)sbr = wu; *(u32x4*)(sbr + 2816) = wg;
                    }
                }
            }
            return;
        }
        float rsv[2][4];
        {
            f32x4 sv[2][4];
#pragma unroll
            for (int ai = 0; ai < 2; ++ai)
#pragma unroll
                for (int m = 0; m < 4; ++m) sv[ai][m] = *(const f32x4*)(ssq + (size_t)(rowb + ai * 128 + m * 16) * 16 + 4 * fq);
#pragma unroll
            for (int ai = 0; ai < 2; ++ai)
#pragma unroll
                for (int m = 0; m < 4; ++m) {
                    float ss = (sv[ai][m][0] + sv[ai][m][1]) + (sv[ai][m][2] + sv[ai][m][3]);
                    ss += __shfl_xor(ss, 16); ss += __shfl_xor(ss, 32);
                    rsv[ai][m] = rsqrtf(ss * (1.0f / DM) + EPS);
                }
        }
#pragma unroll
        for (int ai = 0; ai < 2; ++ai)
#pragma unroll
            for (int m = 0; m < 4; ++m) {
                const int row = rowb + ai * 128 + m * 16;
                const float rs = rsv[ai][m];
                f32x4 v[2][2];
#pragma unroll
                for (int bj = 0; bj < 2; ++bj) { v[bj][0] = acc[ai][bj][m][0] * rs; v[bj][1] = acc[ai][bj][m][1] * rs; }
                if (mode == 1 && u.pn < 8) {
                    const int pos = row & seqmask; const int i0 = wc * 32 + 8 * fq;
#pragma unroll
                    for (int n = 0; n < 2; ++n) {
                        const int ti = ((wc < 2) ? RR_ROW + (pos >> 6) * 64 + i0 : RR_COL + (pos & 63) * 64 + (i0 - 64)) + 4 * n;
                        const f32x4 c = *(const f32x4*)(cosr + ti), s = *(const f32x4*)(cosr + ROPE_N + ti);
                        const f32x4 x1 = v[0][n], x2 = v[1][n];
                        v[0][n] = x1 * c - x2 * s; v[1][n] = x2 * c + x1 * s;
                    }
                }
                if (mode == 0 && u.pn < 3) {
                    const int hh = 4 * u.pn + wc;
                    if (hh < 10) {
                        float ss = 0.f;
#pragma unroll
                        for (int bj = 0; bj < 2; ++bj)
#pragma unroll
                            for (int n = 0; n < 2; ++n) ss += (v[bj][n][0] * v[bj][n][0] + v[bj][n][1] * v[bj][n][1]) + (v[bj][n][2] * v[bj][n][2] + v[bj][n][3] * v[bj][n][3]);
                        ss += __shfl_xor(ss, 16); ss += __shfl_xor(ss, 32);
                        const float hrs = rsqrtf(ss * (1.0f / 64.0f) + EPS) * ((hh < 8) ? 0.125f * LOG2E : 1.0f);
                        const float* gp = ((hh < 8) ? qn : kn) + 8 * fq;
                        const int pos = row & seqmask;
#pragma unroll
                        for (int n = 0; n < 2; ++n) {
                            const f32x4 g1 = *(const f32x4*)(gp + 4 * n), g2 = *(const f32x4*)(gp + 32 + 4 * n);
                            const int ti = ((fq < 2) ? RA_ROW + (pos >> 6) * 16 + 8 * fq : RA_COL + (pos & 63) * 16 + 8 * (fq - 2)) + 4 * n;
                            const f32x4 c = *(const f32x4*)(cosa + ti), s = *(const f32x4*)(cosa + ROPE_N + ti);
                            const f32x4 y1 = v[0][n] * g1 * hrs, y2 = v[1][n] * g2 * hrs;
                            v[0][n] = y1 * c - y2 * s; v[1][n] = y2 * c + y1 * s;
                        }
                    }
                    bf16_t* orow = O + (size_t)row * ldo + u.pn * 256 + wc * 64 + 8 * fq;
#pragma unroll
                    for (int bj = 0; bj < 2; ++bj) {
                        u32x4 w; w.x = cvtpk(v[bj][0][0], v[bj][0][1]); w.y = cvtpk(v[bj][0][2], v[bj][0][3]); w.z = cvtpk(v[bj][1][0], v[bj][1][1]); w.w = cvtpk(v[bj][1][2], v[bj][1][3]);
                        *(u32x4*)(orow + bj * 32) = w;
                    }
                } else if (mode == 0 && u.pn == 11) {
                    if (wc == 0 && fq < 2) { float* g = gates + (size_t)row * 16 + 8 * fq; *(f32x4*)g = v[0][0]; *(f32x4*)(g + 4) = v[0][1]; }
                } else if (mode == 1 && u.pn < 4) {
                    const int cidx = row >> 7, l = row & 127;
#pragma unroll
                    for (int bj = 0; bj < 2; ++bj) {
                        const int d0 = bj * 128 + wc * 32 + 8 * fq;
                        bf16_t* dst = qt + ((((((size_t)cidx * 4 + u.pn) * 4 + (l >> 5)) * 16 + (d0 >> 4)) * 2 + ((d0 >> 3) & 1)) * 32 + (l & 31)) * 8;
                        u32x4 w; w.x = cvtpk(v[bj][0][0], v[bj][0][1]); w.y = cvtpk(v[bj][0][2], v[bj][0][3]); w.z = cvtpk(v[bj][1][0], v[bj][1][1]); w.w = cvtpk(v[bj][1][2], v[bj][1][3]);
                        *(u32x4*)dst = w;
                    }
                } else {
                    bf16_t* orow = O + (size_t)row * ldo + colb - colsub;
#pragma unroll
                    for (int bj = 0; bj < 2; ++bj) {
                        u32x4 w; w.x = cvtpk(v[bj][0][0], v[bj][0][1]); w.y = cvtpk(v[bj][0][2], v[bj][0][3]); w.z = cvtpk(v[bj][1][0], v[bj][1][1]); w.w = cvtpk(v[bj][1][2], v[bj][1][3]);
                        *(u32x4*)(orow + bj * 128) = w;
                    }
                }
            }
    }
};
struct WDesc { const float* W; int K, N; bf16_t* WT; const float* gain; int cs_lo, cs_hi; float cs; int perm_up, perm_ab; };
__device__ __forceinline__ void get_wdesc(const Params& p, int m, WDesc& d) {
    unsigned char* ws = p.ws;
    d.gain = nullptr; d.cs_lo = 0; d.cs_hi = 0; d.cs = 1.f; d.perm_up = 0; d.perm_ab = 0;
    if (m < 2) { const int j = m; d.W = p.in[5] + (size_t)j * 1024 * 2832; d.K = 1024; d.N = 2832; d.WT = (bf16_t*)(ws + W_ABIN + j * W_ABIN_SZ); d.gain = p.in[2] + (2 * j) * 1024; d.cs_lo = 1280; d.cs_hi = 1792; d.cs = 0.08838834764831845f; d.perm_ab = 1; }
    else if (m < 4) { const int j = m - 2; d.W = p.in[10] + (size_t)j * 1024 * 1024; d.K = 1024; d.N = 1024; d.WT = (bf16_t*)(ws + W_ABOUT + j * W_ABOUT_SZ); }
    else if (m < 6) { const int j = m - 4; d.W = p.in[11] + (size_t)j * 1024 * 6144; d.K = 1024; d.N = 6144; d.WT = (bf16_t*)(ws + W_RETIN + j * W_RETIN_SZ); d.gain = p.in[2] + (2 * j + 1) * 1024; d.cs_lo = 1024; d.cs_hi = 2048; d.cs = 0.0625f; }
    else if (m < 8) { const int j = m - 6; d.W = p.in[14] + (size_t)j * 2048 * 1024; d.K = 2048; d.N = 1024; d.WT = (bf16_t*)(ws + W_RETOUT + j * W_RETOUT_SZ); }
    else if (m < 12) { const int l = m - 8; d.W = p.in[15] + (size_t)l * 1024 * 5632; d.K = 1024; d.N = 5632; d.WT = (bf16_t*)(ws + W_UP + l * W_UP_SZ); d.gain = p.in[3] + l * 1024; d.perm_up = 1; }
    else { const int l = m - 12; d.W = p.in[18] + (size_t)l * 2816 * 1024; d.K = 2816; d.N = 1024; d.WT = (bf16_t*)(ws + W_DOWN + l * W_DOWN_SZ); }
}
__device__ __forceinline__ void transpose_item(const WDesc& d, LAS float* scr, int item, int lane) {
    const int nblk = (d.N + 31) / 32, kb = item / nblk, nb = item % nblk, k0 = 64 * kb, n0 = 32 * nb;
    const int nq = n0 + 4 * (lane & 7);
#pragma unroll
    for (int i = 0; i < 8; ++i) {
        const int kk = i * 8 + (lane >> 3);
        f32x4 v = {0.f, 0.f, 0.f, 0.f};
        if (nq < d.N) v = *(const f32x4*)(d.W + (size_t)(k0 + kk) * d.N + nq);
        if (d.gain) v = v * d.gain[k0 + kk];
        LAS float* sp = scr + kk * 33 + 4 * (lane & 7);
        sp[0] = v[0]; sp[1] = v[1]; sp[2] = v[2]; sp[3] = v[3];
    }
    asm volatile("s_waitcnt lgkmcnt(0)" ::: "memory");
    const int c = lane & 7;
#pragma unroll
    for (int j = 0; j < 4; ++j) { const int n = (lane >> 3) + 8 * j; const LAS float* s = scr + (8 * c) * 33 + n;
        const float sc = (n0 + n >= d.cs_lo && n0 + n < d.cs_hi) ? d.cs : 1.f;
        u32x4 o; o.x = cvtpk(s[0 * 33] * sc, s[1 * 33] * sc); o.y = cvtpk(s[2 * 33] * sc, s[3 * 33] * sc); o.z = cvtpk(s[4 * 33] * sc, s[5 * 33] * sc); o.w = cvtpk(s[6 * 33] * sc, s[7 * 33] * sc);
        int orow = n0 + n;
        if (d.perm_ab && orow < 768) { const int rem = orow & 255; orow = (orow & ~255) + 128 * ((rem >> 5) & 1) + 32 * (rem >> 6) + (rem & 31); }
        if (d.perm_up) { const int isg = orow >= 2816, chn = orow - (isg ? 2816 : 0); orow = (chn >> 7) * 256 + isg * 128 + (chn & 127); }
        *(u32x4*)(d.WT + (size_t)orow * d.K + k0 + 8 * c) = o; }
    asm volatile("s_waitcnt lgkmcnt(0)" ::: "memory");
}
__device__ __forceinline__ void sincos_d(double a, float& c, float& s) {
    const double INV_TWO_PI = 0.15915494309189533577, TWO_PI = 6.283185307179586476925;
    const double k = rint(a * INV_TWO_PI); const double r = (a - k * TWO_PI) * 0.5;
    const double r2 = r * r;
    double sn = 1.0, cs = 1.0, ts = 1.0, tc = 1.0;
#pragma unroll
    for (int i = 1; i <= 12; ++i) { constexpr double one = 1.0; tc *= -r2 * (one / (double)((2 * i - 1) * (2 * i))); ts *= -r2 * (one / (double)((2 * i) * (2 * i + 1))); cs += tc; sn += ts; }
    sn *= r;
    s = (float)(2.0 * sn * cs); c = (float)(1.0 - 2.0 * sn * sn);
}
__device__ __forceinline__ void prologue_phase(const Params& p, LAS unsigned char* lds, int tid, int wave, int lane) {
    LAS float* scr = (LAS float*)(lds + wave * 16384);
    const int gw = blockIdx.x * 8 + wave, NGW = gridDim.x * 8;
    int base = 0;
    for (int m = 0; m < 16; ++m) {
        WDesc d; get_wdesc(p, m, d);
        const int nitems = (d.K / 64) * ((d.N + 31) / 32);
        int first = (gw - base % NGW + NGW) % NGW;
        for (int it = first; it < nitems; it += NGW) transpose_item(d, scr, it, lane);
        base += nitems;
    }
    float* tab = (float*)(p.ws + WS_ROPE);
    const int gt = blockIdx.x * NTHREADS + tid, NGT = gridDim.x * NTHREADS;
    const double LN_THETA = 9.210340371976182736;
    for (int e = gt; e < ROPE_N; e += NGT) {
        int nf, f, idx;
        if (e < RA_COL) { nf = 16; f = e & 15; idx = e >> 4; }
        else if (e < RR_ROW) { nf = 16; f = (e - RA_COL) & 15; idx = (e - RA_COL) >> 4; }
        else if (e < RR_COL) { nf = 64; f = (e - RR_ROW) & 63; idx = (e - RR_ROW) >> 6; }
        else { nf = 64; f = (e - RR_COL) & 63; idx = (e - RR_COL) >> 6; }
        const double inv = exp(-(double)f / (double)nf * LN_THETA);
        float c, s; sincos_d((double)idx * inv, c, s); tab[e] = c; tab[ROPE_N + e] = s;
    }
}
__device__ __forceinline__ void chunk_start_phase(const Params& p, int chunk, int do_start, int do_final, int wave, int lane) {
    const int gw = blockIdx.x * 8 + wave, NGW = gridDim.x * 8;
    float* ssq = (float*)(p.ws + WS_SSQ);
    if (do_start) {
        const float* xin = (chunk == 0) ? p.in[0] : p.in[1] + (size_t)(chunk - 1) * CH_ROWS * DM;
        bf16_t* xb = (bf16_t*)(p.ws + WS_XB);
        for (int r0 = 2 * gw; r0 < CH_ROWS; r0 += 2 * NGW) {
            f32x4 v[2][4];
#pragma unroll
            for (int q = 0; q < 2; ++q) { const f32x4* src = (const f32x4*)(xin + (size_t)(r0 + q) * DM) + lane;
#pragma unroll
                for (int j = 0; j < 4; ++j) v[q][j] = src[64 * j]; }
#pragma unroll
            for (int q = 0; q < 2; ++q) {
                u32x2* db = (u32x2*)(xb + (size_t)(r0 + q) * DM) + lane; float ss = 0.f;
#pragma unroll
                for (int j = 0; j < 4; ++j) { const f32x4 x = v[q][j]; u32x2 w; w.x = cvtpk(x[0], x[1]); w.y = cvtpk(x[2], x[3]); db[64 * j] = w; ss += (x[0] * x[0] + x[1] * x[1]) + (x[2] * x[2] + x[3] * x[3]); }
                ss = wave_sum(ss);
                if (lane < 16) ssq[(size_t)(chunk * CH_ROWS + r0 + q) * 16 + lane] = (lane == 0) ? ss : 0.f;
            }
        }
    }
    if (do_final) {
        const int pc = do_start ? chunk - 1 : chunk;
        const f32x4* g = (const f32x4*)p.in[4] + lane;
        f32x4 gv[4];
#pragma unroll
        for (int j = 0; j < 4; ++j) gv[j] = g[64 * j];
        for (int r0 = 2 * gw; r0 < CH_ROWS; r0 += 2 * NGW) {
            f32x4 v[2][4]; float sv[2];
#pragma unroll
            for (int q = 0; q < 2; ++q) { const size_t row = (size_t)pc * CH_ROWS + r0 + q; sv[q] = (lane < 16) ? ssq[row * 16 + lane] : 0.f; const f32x4* xr = (const f32x4*)(p.out + row * DM) + lane;
#pragma unroll
                for (int j = 0; j < 4; ++j) v[q][j] = xr[64 * j]; }
#pragma unroll
            for (int q = 0; q < 2; ++q) { const size_t row = (size_t)pc * CH_ROWS + r0 + q; const float rs = rsqrtf(wave_sum(sv[q]) * (1.0f / DM) + EPS); f32x4* xr = (f32x4*)(p.out + row * DM) + lane;
#pragma unroll
                for (int j = 0; j < 4; ++j) xr[64 * j] = v[q][j] * rs * gv[j]; }
        }
    }
}
constexpr int LDP_AB = 3072;
__device__ __forceinline__ void prep_phase(const Params& p, int j, int seq_len, int wave, int lane) {
    bf16_t* P = (bf16_t*)(p.ws + WS_BIG1);
    const float qg = p.in[7][j * 64 + lane], kg = p.in[8][j * 64 + lane];
    const float* cosA = (const float*)(p.ws + WS_ROPE); const float* sinA = cosA + 8192 * 32;
    const int gw = blockIdx.x * 8 + wave, NGW = gridDim.x * 8;
    for (int row = gw; row < CH_ROWS; row += NGW) {
        bf16_t* ptr = P + (size_t)row * LDP_AB + lane;
        float x[10];
#pragma unroll
        for (int hh = 0; hh < 10; ++hh) x[hh] = bf2f(ptr[hh * 64]);
        const int pos = row & (seq_len - 1);
        const float c = cosA[pos * 32 + (lane & 31)], s = sinA[pos * 32 + (lane & 31)];
#pragma unroll
        for (int hh = 0; hh < 10; ++hh) {
            const float ss = wave_sum(x[hh] * x[hh]);
            const float rs = rsqrtf(ss * (1.0f / 64.0f) + EPS);
            const float y = x[hh] * rs * ((hh < 8) ? qg : kg);
            const float pr = __shfl_xor(y, 32);
            float o = (lane < 32) ? (y * c - pr * s) : (y * c + pr * s);
            if (hh < 8) o *= 0.125f * LOG2E;
            x[hh] = o;
        }
#pragma unroll
        for (int hh = 0; hh < 10; ++hh) ptr[hh * 64] = f2bf(x[hh]);
    }
}

__device__ __forceinline__ void attn_softmax_tile(f32x16& s0, f32x16& s1, float& l_run) {
    float ps = 0.f;
#pragma unroll
    for (int i = 0; i < 16; ++i) { s0[i] = __builtin_amdgcn_exp2f(s0[i]); s1[i] = __builtin_amdgcn_exp2f(s1[i]); ps += s0[i] + s1[i]; }
    l_run += ps;
}
__device__ __forceinline__ void attn_store_tile(bf16_t* orow, const f32x16& o0, const f32x16& o1, float l_run) {
    l_run += __shfl_xor(l_run, 32);
    const float inv = 1.f / l_run;
#pragma unroll
    for (int g = 0; g < 4; ++g) {
        u32x2 w0; w0.x = cvtpk(o0[4 * g] * inv, o0[4 * g + 1] * inv); w0.y = cvtpk(o0[4 * g + 2] * inv, o0[4 * g + 3] * inv);
        u32x2 w1; w1.x = cvtpk(o1[4 * g] * inv, o1[4 * g + 1] * inv); w1.y = cvtpk(o1[4 * g + 2] * inv, o1[4 * g + 3] * inv);
        *(u32x2*)(orow + 8 * g) = w0; *(u32x2*)(orow + 32 + 8 * g) = w1;
    }
}
__device__ __forceinline__ void attn_unit(const bf16_t* P, bf16_t* MO, LAS unsigned char* lds, int seq_len, int b, int hk, int qb, int tid, int wave, int lane, float negC) {
    constexpr int LD = 72, LDV = 96, TK = 128;
    LAS bf16_t* Kl = (LAS bf16_t*)lds;
    LAS bf16_t* Vl = Kl + 2 * TK * LD;
    const int rowbase = b * seq_len;
    const int r = lane & 31, h = lane >> 5;
    const int hq = hk * 4 + (wave >> 1);
    const int tq = rowbase + qb * 128 + 64 * (wave & 1) + r;
    bf16x8 qfA[4], qfB[4];
#pragma unroll
    for (int s = 0; s < 4; ++s) { qfA[s] = *(const bf16x8*)(P + (size_t)tq * LDP_AB + hq * 64 + 16 * s + 8 * h); qfB[s] = *(const bf16x8*)(P + (size_t)(tq + 32) * LDP_AB + hq * 64 + 16 * s + 8 * h); }
    const int skey = tid >> 3, sch = tid & 7;
    const bf16_t* kp = P + (size_t)(rowbase + skey) * LDP_AB + 512 + hk * 64 + sch * 8;
    const bf16_t* vp = P + (size_t)(rowbase + skey) * LDP_AB + 640 + hk * 64 + sch * 8;
    u32x4 kr0 = *(const u32x4*)kp, vr0 = *(const u32x4*)vp;
    { const u32x4 kr1 = *(const u32x4*)(kp + (size_t)64 * LDP_AB), vr1 = *(const u32x4*)(vp + (size_t)64 * LDP_AB);
      *(LAS u32x4*)(Kl + skey * LD + sch * 8) = kr0; *(LAS u32x4*)(Vl + skey * LDV + sch * 8) = vr0;
      *(LAS u32x4*)(Kl + (skey + 64) * LD + sch * 8) = kr1; *(LAS u32x4*)(Vl + (skey + 64) * LDV + sch * 8) = vr1; }
    __syncthreads();
    float lA = 0.f, lB = 0.f;
    f32x16 oA0 = {}, oA1 = {}, oB0 = {}, oB1 = {};
    const int ntile = seq_len / TK;
    for (int it = 0; it < ntile; ++it) {
        const int cur = it & 1;
#pragma unroll 1
        for (int sub = 0; sub < 2; ++sub) {
            if (it + 1 < ntile) { const size_t off = (size_t)((it + 1) * TK + sub * 64) * LDP_AB; kr0 = *(const u32x4*)(kp + off); vr0 = *(const u32x4*)(vp + off); }
            const LAS bf16_t* Kc = Kl + (cur * TK + sub * 64) * LD; const LAS bf16_t* Vc = Vl + (cur * TK + sub * 64) * LDV;
            f32x16 sA0 = {}, sA1 = {}, sB0 = {}, sB1 = {};
#pragma unroll
            for (int s = 0; s < 4; ++s) {
                const bf16x8 k0 = lds_rows(Kc, LD, 0, 16 * s, lane), k1 = lds_rows(Kc, LD, 32, 16 * s, lane);
                sA0 = mfma32(k0, qfA[s], sA0); sA1 = mfma32(k1, qfA[s], sA1); sB0 = mfma32(k0, qfB[s], sB0); sB1 = mfma32(k1, qfB[s], sB1);
            }
            if (negC != 0.f) {
#pragma unroll
                for (int i = 0; i < 16; ++i) { sA0[i] += negC; sA1[i] += negC; sB0[i] += negC; sB1[i] += negC; }
            }
            attn_softmax_tile(sA0, sA1, lA);
            attn_softmax_tile(sB0, sB1, lB);
#pragma unroll
            for (int s = 0; s < 2; ++s) {
                const bf16x8 pA0 = pack8(sA0, s), pA1 = pack8(sA1, s), pB0 = pack8(sB0, s), pB1 = pack8(sB1, s);
                const bf16x8 v00 = lds_tr_perm(Vc, LDV, 16 * s, 0, lane), v01 = lds_tr_perm(Vc, LDV, 16 * s, 32, lane);
                oA0 = mfma32(v00, pA0, oA0); oA1 = mfma32(v01, pA0, oA1); oB0 = mfma32(v00, pB0, oB0); oB1 = mfma32(v01, pB0, oB1);
                const bf16x8 v10 = lds_tr_perm(Vc, LDV, 32 + 16 * s, 0, lane), v11 = lds_tr_perm(Vc, LDV, 32 + 16 * s, 32, lane);
                oA0 = mfma32(v10, pA1, oA0); oA1 = mfma32(v11, pA1, oA1); oB0 = mfma32(v10, pB1, oB0); oB1 = mfma32(v11, pB1, oB1);
            }
            if (it + 1 < ntile) {
                LAS bf16_t* Kn = Kl + ((cur ^ 1) * TK + sub * 64) * LD; LAS bf16_t* Vn = Vl + ((cur ^ 1) * TK + sub * 64) * LDV;
                *(LAS u32x4*)(Kn + skey * LD + sch * 8) = kr0; *(LAS u32x4*)(Vn + skey * LDV + sch * 8) = vr0;
            }
        }
        __syncthreads();
    }
    attn_store_tile(MO + (size_t)tq * 1024 + hq * 64 + 4 * h, oA0, oA1, lA);
    attn_store_tile(MO + (size_t)(tq + 32) * 1024 + hq * 64 + 4 * h, oB0, oB1, lB);
}

constexpr size_t ML_U = 64 * MiB, ML_N = 96 * MiB, ML_S = 97 * MiB;
__device__ __forceinline__ int ml_unit(int w, int nchunk) {
    const int pk = w >> 1, dir = w & 1, oc = pk % nchunk, sh = pk / nchunk;
    return (sh * 2 + dir) * nchunk + (dir ? nchunk - 1 - oc : oc);
}
__device__ __forceinline__ void mlstm_gate_load(const Params& p, int j, const float* gates, int rowbase, int seq_len, int c, int dir, int head, int l, LAS float* a_k, LAS float* b_l) {
    const float* gbias = p.in[6] + j * 16;
    const int tok = dir ? (seq_len - 1 - (c * 128 + l)) : (c * 128 + l);
    const float* g = gates + (size_t)(rowbase + tok) * 16;
    const float ig = g[(2 * dir) * 4 + head] + gbias[(2 * dir) * 4 + head];
    const float fp = g[(2 * dir + 1) * 4 + head] + gbias[(2 * dir + 1) * 4 + head];
    a_k[l] = ig; b_l[l] = logsigmoidf_(fp);
}
__device__ __forceinline__ void mlstm_local_phase(const Params& p, int j, LAS unsigned char* lds, int seq_len, int tid_in, int wave) {
    constexpr int LD = 136;
    const bf16_t* P = (const bf16_t*)(p.ws + WS_BIG1);
    const float* gates = (const float*)(p.ws + WS_GATES);
    LAS bf16_t* Kl = (LAS bf16_t*)lds; LAS bf16_t* Vl = Kl + 128 * LD;
    LAS float* fs = (LAS float*)(lds + 4 * 128 * LD * 2);
    LAS float* a_k = fs; LAS float* b_l = fs + 128; LAS float* wk = fs + 384; LAS float* npart = fs + 640;
    bf16_t* U = (bf16_t*)(p.ws + WS_BIG2 + ML_U); float* NL = (float*)(p.ws + WS_BIG2 + ML_N); float* SC = (float*)(p.ws + WS_BIG2 + ML_S);
    const int nchunk = seq_len / 128;
    const float* gbias = p.in[6] + j * 16;
    u32x4 pk[4], pv[4]; float pig = 0.f, pfp = 0.f;
#define MLL_LOAD(UU) do { const int c_ = (UU) % nchunk, sidx_ = (UU) / nchunk, dir_ = sidx_ & 1, head_ = (sidx_ >> 1) & 3, rowbase_ = (sidx_ >> 3) * seq_len; \
        _Pragma("unroll") for (int i = 0; i < 4; ++i) { const int piece = tid + NTHREADS * i, l = piece >> 4, ch = piece & 15; \
            const int tok = dir_ ? (seq_len - 1 - (c_ * 128 + l)) : (c_ * 128 + l); \
            const bf16_t* src = P + (size_t)(rowbase_ + tok) * LDP_AB + head_ * 128 + ch * 8; \
            pk[i] = *(const u32x4*)(src + 1280); pv[i] = *(const u32x4*)(src + 1792); } \
        if (tid < 128) { const int tok = dir_ ? (seq_len - 1 - (c_ * 128 + tid)) : (c_ * 128 + tid); const float* g = gates + (size_t)(rowbase_ + tok) * 16; \
            pig = g[(2 * dir_) * 4 + head_] + gbias[(2 * dir_) * 4 + head_]; pfp = g[(2 * dir_ + 1) * 4 + head_] + gbias[(2 * dir_ + 1) * 4 + head_]; } } while (0)
    const int upb = (1024 + gridDim.x - 1) / gridDim.x;
    { const int tid = tid_in; if ((int)blockIdx.x * upb < 1024) { const int u0_ = ml_unit(blockIdx.x * upb, nchunk); MLL_LOAD(u0_); } }
    for (int wi = 0; wi < upb && (int)blockIdx.x * upb + wi < 1024; ++wi) {
        const int uidx = ml_unit(blockIdx.x * upb + wi, nchunk);
        int tid = tid_in; asm volatile("" : "+v"(tid)); const int lane = tid & 63, r = lane & 31, h = lane >> 5;
#pragma unroll
        for (int i = 0; i < 4; ++i) {
            const int piece = tid + NTHREADS * i, l = piece >> 4, ch = piece & 15;
            *(LAS u32x4*)(Kl + l * LD + ch * 8) = pk[i];
            *(LAS u32x4*)(Vl + l * LD + ch * 8) = pv[i];
        }
        if (tid < 128) { a_k[tid] = pig; b_l[tid] = logsigmoidf_(pfp); }
        __syncthreads();
        if (wi + 1 < upb && (int)blockIdx.x * upb + wi + 1 < 1024) { const int un_ = ml_unit(blockIdx.x * upb + wi + 1, nchunk); MLL_LOAD(un_); }
        if (wave == 0) {
            const float lf0 = b_l[2 * lane], lf1 = b_l[2 * lane + 1], ig0 = a_k[2 * lane], ig1 = a_k[2 * lane + 1];
            const float s1 = lf0 + lf1; float x = s1;
#pragma unroll
            for (int off = 1; off < 64; off <<= 1) { const float y = __shfl_up(x, off); if (lane >= off) x += y; }
            const float excl = x - s1, b0 = excl + lf0, b1 = excl + s1;
            const float a0 = ig0 - b0, a1 = ig1 - b1;
            float mxx = fmaxf(a0, a1);
#pragma unroll
            for (int off = 1; off < 64; off <<= 1) mxx = fmaxf(mxx, __shfl_xor(mxx, off));
            wk[2 * lane] = __expf(a0 - mxx); wk[2 * lane + 1] = __expf(a1 - mxx);
            if (lane == 63) { SC[(size_t)uidx * 4 + 0] = mxx; SC[(size_t)uidx * 4 + 1] = b1; }
        }
        __syncthreads();
#pragma unroll
        for (int i = 0; i < 4; ++i) {
            const int piece = tid + NTHREADS * i, l = piece >> 4, ch = piece & 15;
            const float w = wk[l];
            u32x4 v = *(LAS u32x4*)(Vl + l * LD + ch * 8);
            v.x = cvtpk(bflo(v.x) * w, bfhi(v.x) * w); v.y = cvtpk(bflo(v.y) * w, bfhi(v.y) * w); v.z = cvtpk(bflo(v.z) * w, bfhi(v.z) * w); v.w = cvtpk(bflo(v.w) * w, bfhi(v.w) * w);
            *(LAS u32x4*)(Vl + l * LD + ch * 8) = v;
        }
        { const int d = tid & 127, kq = tid >> 7; float acc = 0.f;
#pragma unroll 8
          for (int k = kq * 32; k < kq * 32 + 32; ++k) acc += wk[k] * bf2f(Kl[k * LD + d]);
          npart[kq * 128 + d] = acc; }
        __syncthreads();
        {
            const int et = wave >> 1, dt0 = 2 * (wave & 1);
            f32x16 c0 = {}, c1 = {};
#pragma unroll
            for (int s = 0; s < 8; ++s) { const bf16x8 A = lds_tr(Vl, LD, 16 * s, 32 * et, lane);
                c0 = mfma32(A, lds_tr(Kl, LD, 16 * s, 32 * dt0, lane), c0); c1 = mfma32(A, lds_tr(Kl, LD, 16 * s, 32 * dt0 + 32, lane), c1); }
            bf16_t* Uu = U + (size_t)uidx * 16384;
#pragma unroll
            for (int g = 0; g < 4; ++g) {
                u32x2 w0; w0.x = cvtpk(c0[4 * g], c0[4 * g + 1]); w0.y = cvtpk(c0[4 * g + 2], c0[4 * g + 3]);
                u32x2 w1; w1.x = cvtpk(c1[4 * g], c1[4 * g + 1]); w1.y = cvtpk(c1[4 * g + 2], c1[4 * g + 3]);
                *(u32x2*)(Uu + (32 * dt0 + r) * 128 + 32 * et + 8 * g + 4 * h) = w0;
                *(u32x2*)(Uu + (32 * dt0 + 32 + r) * 128 + 32 * et + 8 * g + 4 * h) = w1;
            }
            if (tid < 128) NL[(size_t)uidx * 128 + tid] = (npart[tid] + npart[128 + tid]) + (npart[256 + tid] + npart[384 + tid]);
        }
        __syncthreads();
    }
#undef MLL_LOAD
}
__device__ __forceinline__ void mlstm_combine_phase(const Params& p, LAS unsigned char* lds, int seq_len, int tid) {
    unsigned* U = (unsigned*)(p.ws + WS_BIG2 + ML_U); float* NL = (float*)(p.ws + WS_BIG2 + ML_N); float* SC = (float*)(p.ws + WS_BIG2 + ML_S);
    LAS float* keepv = (LAS float*)lds; LAS float* scv = keepv + 64;
    const int nchunk = seq_len / 128, nscan = 1024 / nchunk;
    for (int sl = blockIdx.x; sl < nscan * 16; sl += gridDim.x) {
        const int sidx = sl >> 4, eb = sl & 15;
        const size_t u0 = (size_t)sidx * nchunk;
        if (tid < 64) {
            const float pmv = (tid < nchunk) ? SC[(u0 + tid) * 4 + 0] : 0.f, blv = (tid < nchunk) ? SC[(u0 + tid) * 4 + 1] : 0.f;
            float m = 0.f, mst = 0.f;
            for (int c = 0; c < nchunk; ++c) {
                const float pm = __shfl(pmv, c), bl = __shfl(blv, c);
                const float Ml = fmaxf(m, pm);
                if (tid == c) { keepv[c] = __expf(m - Ml); scv[c] = __expf(pm - Ml); mst = m; }
                m = bl + Ml;
            }
            if (tid < nchunk && eb == 0) SC[(u0 + tid) * 4 + 2] = mst;
        }
        __syncthreads();
        unsigned* up = U + u0 * 8192 + eb * 512 + tid;
        float C0 = 0.f, C1 = 0.f;
        for (int c0 = 0; c0 < nchunk; c0 += 8) {
            unsigned uu[8];
#pragma unroll
            for (int i = 0; i < 8; ++i) uu[i] = up[(size_t)(c0 + i) * 8192];
#pragma unroll
            for (int i = 0; i < 8; ++i) { up[(size_t)(c0 + i) * 8192] = cvtpk(C0, C1); const float kp = keepv[c0 + i], sc = scv[c0 + i]; C0 = kp * C0 + sc * bflo(uu[i]); C1 = kp * C1 + sc * bfhi(uu[i]); }
        }
        if (eb == 0 && tid < 128) {
            float* np = NL + u0 * 128 + tid; float nn = 0.f;
            for (int c0 = 0; c0 < nchunk; c0 += 8) {
                float nl[8];
#pragma unroll
                for (int i = 0; i < 8; ++i) nl[i] = np[(size_t)(c0 + i) * 128];
#pragma unroll
                for (int i = 0; i < 8; ++i) { np[(size_t)(c0 + i) * 128] = nn; nn = keepv[c0 + i] * nn + scv[c0 + i] * nl[i]; }
            }
        }
        __syncthreads();
    }
}
__device__ __forceinline__ void mlstm_out_phase(const Params& p, int j, LAS unsigned char* lds, int seq_len, int tid_in, int wave) {
    constexpr int LD = 136;
    const bf16_t* P = (const bf16_t*)(p.ws + WS_BIG1);
    const float* gates = (const float*)(p.ws + WS_GATES);
    LAS bf16_t* Ql = (LAS bf16_t*)lds; LAS bf16_t* Kl = Ql + 128 * LD; LAS bf16_t* Vl = Kl + 128 * LD; LAS bf16_t* Cl = Vl + 128 * LD;
    LAS float* fs = (LAS float*)(lds + 4 * 128 * LD * 2);
    LAS float* a_k = fs; LAS float* b_l = fs + 128; LAS float* M_l = fs + 256; LAS float* nvec = fs + 512; LAS float* scal = fs + 1152;
    const bf16_t* U = (const bf16_t*)(p.ws + WS_BIG2 + ML_U); const float* NL = (const float*)(p.ws + WS_BIG2 + ML_N); const float* SC = (const float*)(p.ws + WS_BIG2 + ML_S);
    const int nchunk = seq_len / 128;
    const float* gbias = p.in[6] + j * 16;
    u32x4 pq[4], pk[4], pv[4], pc[4]; float pig = 0.f, pfp = 0.f, pnv = 0.f, pm = 0.f;
#define MLO_LOAD(UU) do { const int c_ = (UU) % nchunk, sidx_ = (UU) / nchunk, dir_ = sidx_ & 1, head_ = (sidx_ >> 1) & 3, rowbase_ = (sidx_ >> 3) * seq_len; \
        _Pragma("unroll") for (int i = 0; i < 4; ++i) { const int piece = tid + NTHREADS * i, l = piece >> 4, ch = piece & 15; \
            const int tok = dir_ ? (seq_len - 1 - (c_ * 128 + l)) : (c_ * 128 + l); \
            const bf16_t* src = P + (size_t)(rowbase_ + tok) * LDP_AB + head_ * 128 + ch * 8; \
            pq[i] = *(const u32x4*)(src + 768); pk[i] = *(const u32x4*)(src + 1280); pv[i] = *(const u32x4*)(src + 1792); \
            pc[i] = *(const u32x4*)(U + (size_t)(UU) * 16384 + l * 128 + ch * 8); } \
        if (tid < 128) { const int tok = dir_ ? (seq_len - 1 - (c_ * 128 + tid)) : (c_ * 128 + tid); const float* g = gates + (size_t)(rowbase_ + tok) * 16; \
            pig = g[(2 * dir_) * 4 + head_] + gbias[(2 * dir_) * 4 + head_]; pfp = g[(2 * dir_ + 1) * 4 + head_] + gbias[(2 * dir_ + 1) * 4 + head_]; pnv = NL[(size_t)(UU) * 128 + tid]; } \
        pm = SC[(size_t)(UU) * 4 + 2]; } while (0)
    const int upb = (1024 + gridDim.x - 1) / gridDim.x;
    { const int tid = tid_in; if ((int)blockIdx.x * upb < 1024) { const int u0_ = ml_unit(blockIdx.x * upb, nchunk); MLO_LOAD(u0_); } }
    for (int wi = 0; wi < upb && (int)blockIdx.x * upb + wi < 1024; ++wi) {
        const int uidx = ml_unit(blockIdx.x * upb + wi, nchunk);
        int tid = tid_in; asm volatile("" : "+v"(tid)); const int lane = tid & 63, r = lane & 31, h = lane >> 5;
        const int c = uidx % nchunk, sidx = uidx / nchunk, dir = sidx & 1, head = (sidx >> 1) & 3, b = sidx >> 3;
        const int rowbase = b * seq_len;
        bf16_t* H = (bf16_t*)(p.ws + WS_BIG2 + (dir ? 48 : 32) * MiB);
#pragma unroll
        for (int i = 0; i < 4; ++i) {
            const int piece = tid + NTHREADS * i, l = piece >> 4, ch = piece & 15;
            *(LAS u32x4*)(Ql + l * LD + ch * 8) = pq[i]; *(LAS u32x4*)(Kl + l * LD + ch * 8) = pk[i];
            *(LAS u32x4*)(Vl + l * LD + ch * 8) = pv[i]; *(LAS u32x4*)(Cl + l * LD + ch * 8) = pc[i];
        }
        if (tid < 128) { a_k[tid] = pig; b_l[tid] = logsigmoidf_(pfp); nvec[tid] = pnv; }
        if (tid == 0) scal[0] = pm;
        __syncthreads();
        if (wi + 1 < upb && (int)blockIdx.x * upb + wi + 1 < 1024) { const int un_ = ml_unit(blockIdx.x * upb + wi + 1, nchunk); MLO_LOAD(un_); }
        if (wave == 0) {
            const float lf0 = b_l[2 * lane], lf1 = b_l[2 * lane + 1], ig0 = a_k[2 * lane], ig1 = a_k[2 * lane + 1];
            const float s1 = lf0 + lf1; float x = s1;
#pragma unroll
            for (int off = 1; off < 64; off <<= 1) { const float y = __shfl_up(x, off); if (lane >= off) x += y; }
            const float excl = x - s1, b0 = excl + lf0, b1 = excl + s1;
            const float a0 = ig0 - b0, a1 = ig1 - b1;
            float mxx = fmaxf(a0, a1);
#pragma unroll
            for (int off = 1; off < 64; off <<= 1) { const float y = __shfl_up(mxx, off); if (lane >= off) mxx = fmaxf(mxx, y); }
            float exm = __shfl_up(mxx, 1); if (lane == 0) exm = -1e30f;
            const float m_old = scal[0];
            b_l[2 * lane] = b0; b_l[2 * lane + 1] = b1; a_k[2 * lane] = a0; a_k[2 * lane + 1] = a1;
            M_l[2 * lane] = fmaxf(m_old, fmaxf(exm, a0)); M_l[2 * lane + 1] = fmaxf(m_old, mxx);
        }
        __syncthreads();
        {
            const int qb = wave & 3, eh = wave >> 2, l = 32 * qb + r;
            bf16x8 qf[8];
#pragma unroll
            for (int s = 0; s < 8; ++s) qf[s] = lds_rows(Ql, LD, 32 * qb, 16 * s, lane);
            const float M = M_l[l], m_old = scal[0], bl = b_l[l];
            const float interw = __expf(m_old - M);
            float qn = 0.f;
#pragma unroll
            for (int s = 0; s < 8; ++s)
#pragma unroll
                for (int jj = 0; jj < 8; ++jj) qn += bf2f((bf16_t)qf[s][jj]) * nvec[16 * s + 8 * h + jj];
            qn += __shfl_xor(qn, 32);
            f32x16 o0 = {}, o1 = {};
#pragma unroll
            for (int s = 0; s < 8; ++s) { o0 = mfma32(lds_tr(Cl, LD, 16 * s, eh * 64, lane), qf[s], o0); o1 = mfma32(lds_tr(Cl, LD, 16 * s, eh * 64 + 32, lane), qf[s], o1); }
#pragma unroll
            for (int i = 0; i < 16; ++i) { o0[i] *= interw; o1[i] *= interw; }
            float dsum = 0.f;
            for (int kt = 0; kt <= qb; ++kt) {
                f32x16 sa = {};
#pragma unroll
                for (int s = 0; s < 8; ++s) sa = mfma32(lds_rows(Kl, LD, 32 * kt, 16 * s, lane), qf[s], sa);
#pragma unroll
                for (int i = 0; i < 16; ++i) { const int k = 32 * kt + accrow(i, h); const float w = (k <= l) ? __expf(a_k[k] - M) * sa[i] : 0.f; dsum += w; sa[i] = w; }
#pragma unroll
                for (int s2 = 0; s2 < 2; ++s2) { const bf16x8 wf = pack8(sa, s2);
                    o0 = mfma32(lds_tr_perm(Vl, LD, 32 * kt + 16 * s2, eh * 64, lane), wf, o0);
                    o1 = mfma32(lds_tr_perm(Vl, LD, 32 * kt + 16 * s2, eh * 64 + 32, lane), wf, o1); }
            }
            dsum += __shfl_xor(dsum, 32);
            const float den = dsum + interw * qn;
            const float inv = 1.f / fmaxf(fabsf(den), __expf(-(bl + M)));
            const int tok = dir ? (seq_len - 1 - (c * 128 + l)) : (c * 128 + l);
            bf16_t* hrow = H + (size_t)(rowbase + tok) * 512 + head * 128 + eh * 64 + 4 * h;
#pragma unroll
            for (int g = 0; g < 4; ++g) {
                u32x2 w0; w0.x = cvtpk(o0[4 * g] * inv, o0[4 * g + 1] * inv); w0.y = cvtpk(o0[4 * g + 2] * inv, o0[4 * g + 3] * inv);
                u32x2 w1; w1.x = cvtpk(o1[4 * g] * inv, o1[4 * g + 1] * inv); w1.y = cvtpk(o1[4 * g + 2] * inv, o1[4 * g + 3] * inv);
                *(u32x2*)(hrow + 8 * g) = w0; *(u32x2*)(hrow + 32 + 8 * g) = w1;
            }
        }
        __syncthreads();
    }
#undef MLO_LOAD
}

__device__ __forceinline__ void mix_phase(const Params& p, int j, LAS unsigned char* lds, int seq_len, int tid, int wave, int lane) {
    mlstm_combine_phase(p, lds, seq_len, tid);
    const int nseq = CH_ROWS / seq_len;
    const bf16_t* P = (const bf16_t*)(p.ws + WS_BIG1); bf16_t* MO = (bf16_t*)(p.ws + WS_BIG2);
    const int nqb = seq_len / 128, units = nseq * nqb * 2;
    float negC;
    { float gq = fabsf(p.in[7][j * 64 + lane]), gk = fabsf(p.in[8][j * 64 + lane]);
#pragma unroll
      for (int o = 1; o < 64; o <<= 1) { gq = fmaxf(gq, __shfl_xor(gq, o)); gk = fmaxf(gk, __shfl_xor(gk, o)); }
      negC = -(64.0f * 0.125f * LOG2E * 1.03f) * gq * gk; if (negC > -60.f) negC = 0.f; }
    for (int u0 = blockIdx.x; u0 < units; u0 += gridDim.x) {
        int pair, qb;
        if (gridDim.x == 256) {
            const int x = u0 & 7, idx = u0 >> 3;
            if (nqb == 64) { pair = x >> 1; qb = (x & 1) * 32 + idx; } else { pair = 2 * x + (idx >> 4); qb = idx & 15; }
        } else { pair = u0 / nqb; qb = u0 % nqb; }
        attn_unit(P, MO, lds, seq_len, pair >> 1, pair & 1, qb, tid, wave, lane, negC);
    }
}

__device__ __forceinline__ void fin_ab_phase(const Params& p, int j, int wave, int lane) {
    const bf16_t* P = (const bf16_t*)(p.ws + WS_BIG1); bf16_t* MO = (bf16_t*)(p.ws + WS_BIG2);
    const bf16_t* hf = (const bf16_t*)(p.ws + WS_BIG2 + 32 * MiB); const bf16_t* hb = (const bf16_t*)(p.ws + WS_BIG2 + 48 * MiB);
    const float* gn = p.in[9] + j * 512;
    float g0[4], g1[4];
#pragma unroll
    for (int head = 0; head < 4; ++head) { g0[head] = gn[head * 128 + 2 * lane]; g1[head] = gn[head * 128 + 2 * lane + 1]; }
    const int gw = blockIdx.x * 8 + wave, NGW = gridDim.x * 8;
    for (int row = gw; row < CH_ROWS; row += NGW) {
        unsigned a[4], bb[4], mo[4];
#pragma unroll
        for (int head = 0; head < 4; ++head) {
            a[head] = *(const unsigned*)(hf + (size_t)row * 512 + head * 128 + 2 * lane); bb[head] = *(const unsigned*)(hb + (size_t)row * 512 + head * 128 + 2 * lane);
            mo[head] = *(const unsigned*)(P + (size_t)row * LDP_AB + 2304 + head * 128 + 2 * lane);
        }
#pragma unroll
        for (int head = 0; head < 4; ++head) {
            const float s0 = bflo(a[head]) + bflo(bb[head]), s1 = bfhi(a[head]) + bfhi(bb[head]);
            const float ss = wave_sum(s0 * s0 + s1 * s1);
            const float rs = rsqrtf(ss * (1.0f / 128.0f) + EPS);
            *(unsigned*)(MO + (size_t)row * 1024 + 512 + head * 128 + 2 * lane) = cvtpk(s0 * rs * g0[head] * sigmoidf_(bflo(mo[head])), s1 * rs * g1[head] * sigmoidf_(bfhi(mo[head])));
        }
    }
}
constexpr int LDP_R = 5120;
constexpr size_t QT_OFF = 160 * MiB;
__device__ __forceinline__ void ret_scan(const Params& p, int j, LAS unsigned char* lds, int seq_len, int u, int tid_in, int wave, int variant) {
    constexpr int LDK = 288, LDV = 72;
    const bf16_t* P = (const bf16_t*)(p.ws + WS_BIG1);
    const bf16_t* QT = (const bf16_t*)(p.ws + WS_BIG1 + QT_OFF);
    LAS bf16_t* Kl = (LAS bf16_t*)lds; LAS bf16_t* Vl = Kl + 128 * LDK; LAS bf16_t* Cl = Vl + 128 * LDV;
    const int slice = u & 7, dir = (u >> 3) & 1, head = (u >> 4) & 3, b = u >> 6;
    const int rowbase = b * seq_len;
    bf16_t* Y = (bf16_t*)(p.ws + WS_BIG2 + (dir ? 64 : 0) * MiB);
    const float lg = logsigmoidf_(p.in[12][j * 8 + dir * 4 + head]);
    const float cd = __expf(lg * 128.f);
    f32x16 cacc0 = {}, cacc1 = {};
    for (int i = tid_in; i < 256 * LDV / 2; i += NTHREADS) ((LAS unsigned*)Cl)[i] = 0u;
    const int nchunk = seq_len / 128;
    const int qb = wave & 3, etq = wave >> 2;
    const int etu = wave & 1, dt0 = (wave >> 1) * 2;
    u32x4 kr[8], vr[2]; bf16x8 qf[16];
#define RS_LOADKV(cc) do { _Pragma("unroll") for (int i = 0; i < 8; ++i) { const int piece = tid + NTHREADS * i, l = piece >> 5, ch = piece & 31; \
            const int tok = dir ? (seq_len - 1 - ((cc) * 128 + l)) : ((cc) * 128 + l); \
            kr[i] = *(const u32x4*)(P + (size_t)(rowbase + tok) * LDP_R + head * 256 + ch * 8); } \
        _Pragma("unroll") for (int i = 0; i < 2; ++i) { const int piece = tid + NTHREADS * i, l = piece >> 3, ch = piece & 7; \
            const int tok = dir ? (seq_len - 1 - ((cc) * 128 + l)) : ((cc) * 128 + l); \
            vr[i] = *(const u32x4*)(P + (size_t)(rowbase + tok) * LDP_R + 1024 + head * 512 + slice * 64 + ch * 8); } } while (0)
#define RS_STOREKV() do { _Pragma("unroll") for (int i = 0; i < 8; ++i) { const int piece = tid + NTHREADS * i, l = piece >> 5, ch = piece & 31; *(LAS u32x4*)(Kl + l * LDK + ch * 8) = kr[i]; } \
        _Pragma("unroll") for (int i = 0; i < 2; ++i) { const int piece = tid + NTHREADS * i, l = piece >> 3, ch = piece & 7; u32x4 v = vr[i]; const float w = __expf(lg * (float)(127 - l)); \
            v.x = cvtpk(bflo(v.x) * w, bfhi(v.x) * w); v.y = cvtpk(bflo(v.y) * w, bfhi(v.y) * w); v.z = cvtpk(bflo(v.z) * w, bfhi(v.z) * w); v.w = cvtpk(bflo(v.w) * w, bfhi(v.w) * w); \
            *(LAS u32x4*)(Vl + l * LDV + ch * 8) = v; } } while (0)
#define RS_LOADQ(cc) do { const int oc = dir ? (nchunk - 1 - (cc)) : (cc); const int cidx = (rowbase >> 7) + oc; const int qbo = dir ? 3 - qb : qb, ro = dir ? 31 - r : r; \
        const bf16_t* qsrc = QT + ((((size_t)cidx * 4 + head) * 4 + qbo) * 1024 + h * 32 + ro) * 8; \
        _Pragma("unroll") for (int s = 0; s < 16; ++s) qf[s] = *(const bf16x8*)(qsrc + s * 512); } while (0)
    {
        int tid = tid_in; asm volatile("" : "+v"(tid)); const int lane = tid & 63, r = lane & 31, h = lane >> 5;
        RS_LOADKV(0); RS_LOADQ(0); RS_STOREKV();
        if (nchunk > 1) RS_LOADKV(1);
    }
    __syncthreads();
    for (int c = 0; c < nchunk; ++c) {
        int tid = tid_in; asm volatile("" : "+v"(tid)); const int lane = tid & 63, r = lane & 31, h = lane >> 5;
        const bool more = (c + 1 < nchunk);
        {
            const int lq = 32 * qb + r;
            const int tokq = dir ? (seq_len - 1 - (c * 128 + lq)) : (c * 128 + lq);
            f32x16 o = {}, ob = {};
            if (!(variant & 2)) {
                bf16x8 fa[2][2];
#pragma unroll
                for (int i = 0; i < 2; ++i) fa[0][i] = lds_tr(Cl, LDV, 16 * i, 32 * etq, lane);
#pragma unroll
                for (int sb = 0; sb < 8; ++sb) {
                    if (sb < 7) {
#pragma unroll
                        for (int i = 0; i < 2; ++i) fa[(sb + 1) & 1][i] = lds_tr(Cl, LDV, 16 * (2 * (sb + 1) + i), 32 * etq, lane);
                    }
                    __builtin_amdgcn_sched_barrier(0);
                    o = mfma32(fa[sb & 1][0], qf[2 * sb + 0], o); ob = mfma32(fa[sb & 1][1], qf[2 * sb + 1], ob);
                    __builtin_amdgcn_sched_barrier(0);
                }
#pragma unroll
                for (int i = 0; i < 16; ++i) o[i] += ob[i];
            }
            const float qd = __expf(lg * (float)(lq + 1));
            bf16_t* yrow = Y + (size_t)(rowbase + tokq) * 2048 + head * 512 + slice * 64 + 32 * etq + 4 * h;
#pragma unroll
            for (int g = 0; g < 4; ++g) { u32x2 w0; w0.x = cvtpk(o[4 * g] * qd, o[4 * g + 1] * qd); w0.y = cvtpk(o[4 * g + 2] * qd, o[4 * g + 3] * qd); if (!(variant & 1)) *(u32x2*)(yrow + 8 * g) = w0; else if (w0.x == 0x12345678u && w0.y == 0x9abcdef0u) *(u32x2*)(yrow + 8 * g) = w0; }
        }
        if (more && !(variant & 8)) RS_LOADQ(c + 1);
#pragma unroll
        for (int i = 0; i < 16; ++i) { cacc0[i] *= cd; cacc1[i] *= cd; }
        if (!(variant & 4)) {
            bf16x8 fu[2][3];
            fu[0][0] = lds_tr(Vl, LDV, 0, 32 * etu, lane); fu[0][1] = lds_tr(Kl, LDK, 0, 32 * dt0, lane); fu[0][2] = lds_tr(Kl, LDK, 0, 32 * dt0 + 32, lane);
#pragma unroll
            for (int s = 0; s < 8; ++s) {
                if (s < 7) { fu[(s + 1) & 1][0] = lds_tr(Vl, LDV, 16 * (s + 1), 32 * etu, lane); fu[(s + 1) & 1][1] = lds_tr(Kl, LDK, 16 * (s + 1), 32 * dt0, lane); fu[(s + 1) & 1][2] = lds_tr(Kl, LDK, 16 * (s + 1), 32 * dt0 + 32, lane); }
                __builtin_amdgcn_sched_barrier(0);
                cacc0 = mfma32(fu[s & 1][0], fu[s & 1][1], cacc0); cacc1 = mfma32(fu[s & 1][0], fu[s & 1][2], cacc1);
                __builtin_amdgcn_sched_barrier(0);
            }
        }
        __syncthreads();
#pragma unroll
        for (int g = 0; g < 4; ++g) {
            u32x2 w0; w0.x = cvtpk(cacc0[4 * g], cacc0[4 * g + 1]); w0.y = cvtpk(cacc0[4 * g + 2], cacc0[4 * g + 3]);
            u32x2 w1; w1.x = cvtpk(cacc1[4 * g], cacc1[4 * g + 1]); w1.y = cvtpk(cacc1[4 * g + 2], cacc1[4 * g + 3]);
            *(LAS u32x2*)(Cl + (32 * dt0 + r) * LDV + 32 * etu + 8 * g + 4 * h) = w0;
            *(LAS u32x2*)(Cl + (32 * dt0 + 32 + r) * LDV + 32 * etu + 8 * g + 4 * h) = w1;
        }
        if (more) RS_STOREKV();
        if (c + 2 < nchunk && !(variant & 8)) RS_LOADKV(c + 2);
        __syncthreads();
    }
#undef RS_LOADKV
#undef RS_STOREKV
#undef RS_LOADQ
}
__device__ __forceinline__ void ret_scan_phase(const Params& p, int j, LAS unsigned char* lds, int seq_len, int tid, int wave, int lane, int variant) {
    const int units = (CH_ROWS / seq_len) * 64;
    if (gridDim.x == 256) {
        const int x = blockIdx.x & 7, idx = blockIdx.x >> 3;
        if (units == 128) { if (idx < 16) ret_scan(p, j, lds, seq_len, ((2 * x + (idx >> 3)) << 3) | (idx & 7), tid, wave, variant); }
        else for (int rr = 0; rr < 2; ++rr) ret_scan(p, j, lds, seq_len, ((8 * x + 4 * rr + (idx >> 3)) << 3) | (idx & 7), tid, wave, variant);
    } else
    for (int u = blockIdx.x; u < units; u += gridDim.x) ret_scan(p, j, lds, seq_len, u, tid, wave, variant);
}
__device__ __forceinline__ void ret_intra_phase(const Params& p, int j, LAS unsigned char* lds, int tid_in, int wave, int lane_in, bool dry) {
    constexpr int LDK = 264, LDVV = 288;
    const bf16_t* P = (const bf16_t*)(p.ws + WS_BIG1);
    bf16_t* Yf = (bf16_t*)(p.ws + WS_BIG2); const bf16_t* Yb = (const bf16_t*)(p.ws + WS_BIG2 + 64 * MiB);
    const float* gn = p.in[13] + j * 2048;
    LAS bf16_t* Kl = (LAS bf16_t*)lds; LAS bf16_t* Vl = Kl + 128 * LDK; LAS float* ssqp = (LAS float*)(lds + 128 * LDK * 2 + 128 * LDVV * 2);
    const int lb = wave & 1, eg = wave >> 1;
    for (int u = blockIdx.x; u < 1024; u += gridDim.x) {
        int tid = tid_in; asm volatile("" : "+v"(tid)); const int lane = tid & 63, r = lane & 31, h = lane >> 5;
        int qh = u & 1, head = (u >> 1) & 3, lc = u >> 3;
        if (gridDim.x == 256) { const int pi = (u & 255) + 256 * (u >> 9); qh = (u >> 8) & 1; head = pi & 3; lc = pi >> 2; }
        const int R0 = lc * 128;
        const float lgf = logsigmoidf_(p.in[12][j * 8 + head]), lgb = logsigmoidf_(p.in[12][j * 8 + 4 + head]);
        const int l = 64 * qh + 32 * lb + r;
        bf16x8 qf[16]; u32x4 kr[8], vr[8];
        { const bf16_t* qsrc = (const bf16_t*)(p.ws + WS_BIG1 + QT_OFF) + ((((size_t)lc * 4 + head) * 4 + (2 * qh + lb)) * 1024 + h * 32 + r) * 8;
#pragma unroll
          for (int s = 0; s < 16; ++s) qf[s] = *(const bf16x8*)(qsrc + s * 512); }
        const bf16_t* rowp = P + (size_t)(R0 + (tid >> 5)) * LDP_R + (tid & 31) * 8;
        const bool sameK = (gridDim.x == 256) && qh == 1;
        if (!sameK) {
#pragma unroll
            for (int i = 0; i < 8; ++i) kr[i] = *(const u32x4*)(rowp + (size_t)(16 * i) * LDP_R + head * 256);
        }
#pragma unroll
        for (int i = 0; i < 8; ++i) vr[i] = *(const u32x4*)(rowp + (size_t)(16 * i) * LDP_R + 1024 + head * 512);
        if (!sameK) {
#pragma unroll
            for (int i = 0; i < 8; ++i) *(LAS u32x4*)(Kl + ((tid >> 5) + 16 * i) * LDK + (tid & 31) * 8) = kr[i];
            __syncthreads();
        }
        bf16x8 wf[4][2];
#pragma unroll
        for (int kt = 0; kt < 4; ++kt) {
            f32x16 sa = {};
#pragma unroll
            for (int s = 0; s < 16; ++s) sa = mfma32(lds_rows(Kl, LDK, 32 * kt, 16 * s, lane), qf[s], sa);
#pragma unroll
            for (int i = 0; i < 16; ++i) { const int k = 32 * kt + accrow(i, h); const int diff = l - k; sa[i] *= (diff >= 0) ? __expf(lgf * (float)diff) : __expf(lgb * (float)(-diff)); }
            wf[kt][0] = pack8(sa, 0); wf[kt][1] = pack8(sa, 1);
        }
#pragma unroll
        for (int i = 0; i < 8; ++i) *(LAS u32x4*)(Vl + ((tid >> 5) + 16 * i) * LDVV + (tid & 31) * 8) = vr[i];
#pragma unroll
        for (int i = 0; i < 8; ++i) vr[i] = *(const u32x4*)(rowp + (size_t)(16 * i) * LDP_R + 1024 + head * 512 + 256);
        __syncthreads();
        f32x16 o[4] = {};
#pragma unroll
        for (int kt = 0; kt < 4; ++kt)
#pragma unroll
            for (int s2 = 0; s2 < 2; ++s2)
#pragma unroll
                for (int e2 = 0; e2 < 2; ++e2)
                    o[e2] = mfma32(lds_tr_perm(Vl, LDVV, 32 * kt + 16 * s2, eg * 64 + 32 * e2, lane), wf[kt][s2], o[e2]);
        __syncthreads();
#pragma unroll
        for (int i = 0; i < 8; ++i) *(LAS u32x4*)(Vl + ((tid >> 5) + 16 * i) * LDVV + (tid & 31) * 8) = vr[i];
        const size_t ybase = (size_t)(R0 + l) * 2048 + head * 512;
        u32x2 ya[16], yb[16];
#pragma unroll
        for (int ti = 0; ti < 4; ++ti)
#pragma unroll
            for (int g = 0; g < 4; ++g) {
                const int e = (ti >> 1) * 256 + eg * 64 + 32 * (ti & 1) + 8 * g + 4 * h;
                ya[ti * 4 + g] = *(const u32x2*)(Yf + ybase + e); yb[ti * 4 + g] = *(const u32x2*)(Yb + ybase + e);
            }
        __syncthreads();
#pragma unroll
        for (int kt = 0; kt < 4; ++kt)
#pragma unroll
            for (int s2 = 0; s2 < 2; ++s2)
#pragma unroll
                for (int e2 = 0; e2 < 2; ++e2)
                    o[2 + e2] = mfma32(lds_tr_perm(Vl, LDVV, 32 * kt + 16 * s2, eg * 64 + 32 * e2, lane), wf[kt][s2], o[2 + e2]);
        u32x2 rgv[16];
#pragma unroll
        for (int ti = 0; ti < 4; ++ti)
#pragma unroll
            for (int g = 0; g < 4; ++g) {
                const int e = (ti >> 1) * 256 + eg * 64 + 32 * (ti & 1) + 8 * g + 4 * h;
                rgv[ti * 4 + g] = *(const u32x2*)(P + (size_t)(R0 + l) * LDP_R + 3072 + head * 512 + e);
            }
        float ss = 0.f;
#pragma unroll
        for (int ti = 0; ti < 4; ++ti)
#pragma unroll
            for (int g = 0; g < 4; ++g) {
                const u32x2 a = ya[ti * 4 + g], bb = yb[ti * 4 + g];
                o[ti][4 * g + 0] += bflo(a.x) + bflo(bb.x); o[ti][4 * g + 1] += bfhi(a.x) + bfhi(bb.x); o[ti][4 * g + 2] += bflo(a.y) + bflo(bb.y); o[ti][4 * g + 3] += bfhi(a.y) + bfhi(bb.y);
                ss += (o[ti][4 * g] * o[ti][4 * g] + o[ti][4 * g + 1] * o[ti][4 * g + 1]) + (o[ti][4 * g + 2] * o[ti][4 * g + 2] + o[ti][4 * g + 3] * o[ti][4 * g + 3]);
            }
        ss += __shfl_xor(ss, 32);
        if (h == 0) ssqp[eg * 64 + 32 * lb + r] = ss;
        __syncthreads();
        const float tot = (ssqp[32 * lb + r] + ssqp[64 + 32 * lb + r]) + (ssqp[128 + 32 * lb + r] + ssqp[192 + 32 * lb + r]);
        const float rs = rsqrtf(tot * (1.0f / 512.0f) + EPS);
#pragma unroll
        for (int ti = 0; ti < 4; ++ti)
#pragma unroll
            for (int g = 0; g < 4; ++g) {
                const int e = (ti >> 1) * 256 + eg * 64 + 32 * (ti & 1) + 8 * g + 4 * h;
                const f32x4 gv = *(const f32x4*)(gn + head * 512 + e);
                const u32x2 rg = rgv[ti * 4 + g];
                const float g0 = bflo(rg.x), g1 = bfhi(rg.x), g2 = bflo(rg.y), g3 = bfhi(rg.y);
                u32x2 w; w.x = cvtpk(o[ti][4 * g] * rs * gv[0] * g0 * sigmoidf_(g0), o[ti][4 * g + 1] * rs * gv[1] * g1 * sigmoidf_(g1));
                w.y = cvtpk(o[ti][4 * g + 2] * rs * gv[2] * g2 * sigmoidf_(g2), o[ti][4 * g + 3] * rs * gv[3] * g3 * sigmoidf_(g3));
                if (!dry) *(u32x2*)(Yf + ybase + e) = w;
            }
        __syncthreads();
    }
}
__device__ __forceinline__ void act_fix_phase(const Params& p, int layer, int seq_len, int tid) {
    const bf16_t* SB = (const bf16_t*)(p.ws + WS_BIG1); bf16_t* ACT = (bf16_t*)(p.ws + WS_BIG2);
    const float* cw = p.in[16] + (size_t)layer * 3 * 2816; const float* cb = p.in[17] + (size_t)layer * 2816;
    const int gt = blockIdx.x * NTHREADS + tid, NGT = gridDim.x * NTHREADS;
    for (int it = gt; it < 512 * 352; it += NGT) {
        const int rr = it / 352, c = (it % 352) * 8;
        const int k = rr >> 1, last = rr & 1;
        const int row = 64 * k + (last ? 63 : 0);
        const int pos = row & (seq_len - 1);
        const bf16_t* sb = SB + (size_t)k * 4 * 5632 + c;
        u32x4 uv, g0, gm = {0u, 0u, 0u, 0u}, gp = {0u, 0u, 0u, 0u};
        if (last) { uv = *(const u32x4*)(sb + 1 * 5632); g0 = *(const u32x4*)(sb + 1 * 5632 + 2816); gm = *(const u32x4*)(sb + 0 * 5632 + 2816); if (pos < seq_len - 1) gp = *(const u32x4*)(sb + (4 + 2) * 5632 + 2816); }
        else { uv = *(const u32x4*)(sb + 2 * 5632); g0 = *(const u32x4*)(sb + 2 * 5632 + 2816); gp = *(const u32x4*)(sb + 3 * 5632 + 2816); if (pos > 0) gm = *(const u32x4*)(sb + (-4 + 1) * 5632 + 2816); }
        const f32x4 w0a = *(const f32x4*)(cw + c), w0b = *(const f32x4*)(cw + c + 4), w1a = *(const f32x4*)(cw + 2816 + c), w1b = *(const f32x4*)(cw + 2816 + c + 4);
        const f32x4 w2a = *(const f32x4*)(cw + 5632 + c), w2b = *(const f32x4*)(cw + 5632 + c + 4), ba = *(const f32x4*)(cb + c), bb = *(const f32x4*)(cb + c + 4);
        float y[8];
#pragma unroll
        for (int q = 0; q < 4; ++q) {
            const unsigned a = (q == 0) ? gm.x : (q == 1) ? gm.y : (q == 2) ? gm.z : gm.w;
            const unsigned bq = (q == 0) ? g0.x : (q == 1) ? g0.y : (q == 2) ? g0.z : g0.w;
            const unsigned cq = (q == 0) ? gp.x : (q == 1) ? gp.y : (q == 2) ? gp.z : gp.w;
            const unsigned uq = (q == 0) ? uv.x : (q == 1) ? uv.y : (q == 2) ? uv.z : uv.w;
            const int e0 = 2 * q, e1 = 2 * q + 1;
            const float k00 = (e0 < 4) ? w0a[e0 & 3] : w0b[e0 & 3], k10 = (e0 < 4) ? w1a[e0 & 3] : w1b[e0 & 3], k20 = (e0 < 4) ? w2a[e0 & 3] : w2b[e0 & 3], b0 = (e0 < 4) ? ba[e0 & 3] : bb[e0 & 3];
            const float k01 = (e1 < 4) ? w0a[e1 & 3] : w0b[e1 & 3], k11 = (e1 < 4) ? w1a[e1 & 3] : w1b[e1 & 3], k21 = (e1 < 4) ? w2a[e1 & 3] : w2b[e1 & 3], b1 = (e1 < 4) ? ba[e1 & 3] : bb[e1 & 3];
            const float y0 = bflo(a) * k00 + bflo(bq) * k10 + bflo(cq) * k20 + b0;
            const float y1 = bfhi(a) * k01 + bfhi(bq) * k11 + bfhi(cq) * k21 + b1;
            y[e0] = gelu_as(y0) * bflo(uq); y[e1] = gelu_as(y1) * bfhi(uq);
        }
        u32x4 w; w.x = cvtpk(y[0], y[1]); w.y = cvtpk(y[2], y[3]); w.z = cvtpk(y[4], y[5]); w.w = cvtpk(y[6], y[7]);
        *(u32x4*)(ACT + (size_t)row * 2816 + c) = w;
    }
}
typedef const __attribute__((address_space(4))) Params* KParamsPtr;
#if defined(__HIP_DEVICE_COMPILE__)
#define RELOAD_PARAMS() KParamsPtr kq_ = kp_; asm volatile("" : "+s"(kq_)); const Params p = *kq_
#else
#define RELOAD_PARAMS() const Params p = p_arg
#endif
__global__ void __launch_bounds__(NTHREADS) __attribute__((amdgpu_waves_per_eu(2, 2))) mega_fwd(Params p_arg) {
#if defined(__HIP_DEVICE_COMPILE__)
    const KParamsPtr kp_ = (KParamsPtr)__builtin_amdgcn_kernarg_segment_ptr();
#endif
    unsigned char* const ws_top = p_arg.ws;
    extern __shared__ __attribute__((aligned(16))) unsigned char lds_raw[];
    LAS unsigned char* lds = (LAS unsigned char*)lds_raw;
    cg::grid_group grid = cg::this_grid();
    const int tid0 = threadIdx.x;
    unsigned char* ws = ws_top;
    volatile LAS unsigned* bst = (volatile LAS unsigned*)(lds + LDS_BYTES - 64);
    if (tid0 < 16) bst[tid0] = 0u;
    __syncthreads();
    XcdBarrier bar = xcd_barrier_post((unsigned*)(ws + WS_CTL), bst);

    { RELOAD_PARAMS(); const int tid = tid0, lane = tid & 63, wave = __builtin_amdgcn_readfirstlane(tid >> 6); prologue_phase(p, lds, tid, wave, lane); chunk_start_phase(p, 0, 1, 0, wave, lane); }
    grid.sync();
    for (int chunk = 0; chunk < 3; ++chunk) {
        const int seq_len = (chunk == 0) ? 8192 : 2048;
        const size_t row0 = (size_t)chunk * CH_ROWS;
        { RELOAD_PARAMS(); int tid = tid0; asm volatile("" : "+v"(tid)); const int lane = tid & 63, wave = __builtin_amdgcn_readfirstlane(tid >> 6); if (chunk > 0) chunk_start_phase(p, chunk, 1, 1, wave, lane); }
        if (chunk > 0) xcd_barrier(bar);
        for (int layer = 0; layer < 4; ++layer) {
            const int j = layer >> 1; const bool even = (layer & 1) == 0;
            for (int step = 0; step < 8; ++step) {
                const bool isg = (step == 0 || step == 4 || step == 5 || step == 7);
                const int pbit = isg ? 1 : (step == 1 ? (even ? 0 : 4) : (step == 2 ? 0 : (step == 3 ? 0 : 8)));
                const int reps = (PROBE_MASK & pbit) ? 2 : 1;
                for (int rep = 0; rep < reps; ++rep) {
                RELOAD_PARAMS(); unsigned char* ws = p.ws;
                int tid = tid0; asm volatile("" : "+v"(tid)); const int lane = tid & 63, wave = __builtin_amdgcn_readfirstlane(tid >> 6);
                if (step == 0 || step == 4 || step == 5 || step == 7) {
                    pg8::Gemm g; EpiF E; int emode = 0;
                    E.O = (bf16_t*)(ws + WS_BIG1); E.ldo = 0; E.ssq = (const float*)(ws + WS_SSQ) + row0 * 16; E.gates = (float*)(ws + WS_GATES);
                    E.qt = (bf16_t*)(ws + WS_BIG1 + QT_OFF); E.colsub = 0; E.qn = p.in[7] + j * 64; E.kn = p.in[8] + j * 64; E.cosa = (const float*)(ws + WS_ROPE); E.sina = E.cosa + ROPE_N; E.act = (bf16_t*)(ws + WS_BIG2); E.sb = (bf16_t*)(ws + WS_BIG1); E.cw = p.in[16] + (size_t)layer * 3 * 2816; E.cb = p.in[17] + (size_t)layer * 2816; E.cosr = (const float*)(ws + WS_ROPE); E.sinr = E.cosr + ROPE_N; E.seqmask = seq_len - 1;
                    E.x = (step == 7 && layer == 3) ? p.out + row0 * DM : nullptr; E.xb = (bf16_t*)(ws + WS_XB); E.ssq_out = (float*)(ws + WS_SSQ) + row0 * 16;
                    g.M = CH_ROWS;
                    if (step == 0) {
                        g.A = (const pg8::bf16_t*)(ws + WS_XB); g.K = 1024;
                        if (even) { g.Bt = (const pg8::bf16_t*)(ws + W_ABIN + j * W_ABIN_SZ); g.N = 3072; emode = 0; E.ldo = 3072; }
                        else { g.Bt = (const pg8::bf16_t*)(ws + W_RETIN + j * W_RETIN_SZ); g.N = 6144; emode = 1; E.ldo = 5120; E.colsub = 1024; }
                    } else if (step == 4) {
                        g.A = (const pg8::bf16_t*)(ws + WS_BIG2); g.N = 1024; emode = 3;
                        if (even) { g.Bt = (const pg8::bf16_t*)(ws + W_ABOUT + j * W_ABOUT_SZ); g.K = 1024; }
                        else { g.Bt = (const pg8::bf16_t*)(ws + W_RETOUT + j * W_RETOUT_SZ); g.K = 2048; }
                    } else if (step == 5) {
                        g.A = (const pg8::bf16_t*)(ws + WS_XB); g.K = 1024; g.Bt = (const pg8::bf16_t*)(ws + W_UP + layer * W_UP_SZ); g.N = 5632; emode = 2; E.ldo = 5632;
                    } else {
                        g.A = (const pg8::bf16_t*)(ws + WS_BIG2); g.K = 2816; g.Bt = (const pg8::bf16_t*)(ws + W_DOWN + layer * W_DOWN_SZ); g.N = 1024; emode = 3;
                    }
                    pg8::StaticOrder S; S.init(g.M, g.N, (int)gridDim.x, (int)blockIdx.x);
                    if (emode == 0) { EpiT<0> ET; (EpiF&)ET = E; pg8::gemm_phase<EpiT<0>, pg8::StaticOrder, true, true>(lds, g, S, ET); }
                    else if (emode == 1) { EpiT<1> ET; (EpiF&)ET = E; pg8::gemm_phase<EpiT<1>, pg8::StaticOrder, true, true>(lds, g, S, ET); }
                    else if (emode == 2) { EpiT<2> ET; (EpiF&)ET = E; pg8::gemm_phase<EpiT<2>, pg8::StaticOrder, true, true>(lds, g, S, ET); }
                    else { EpiT<3> ET; (EpiF&)ET = E; pg8::gemm_phase<EpiT<3>, pg8::StaticOrder, true, true>(lds, g, S, ET); }
                } else if (step == 1) {
                    if (even) { mlstm_local_phase(p, j, lds, seq_len, tid, wave); if (PROBE_MASK & 2048) mlstm_local_phase(p, j, lds, seq_len, tid, wave); } else ret_scan_phase(p, j, lds, seq_len, tid, wave, lane, (rep == 0) ? 0 : PROBE_VAR);
                } else if (step == 2) {
                    if (even) mix_phase(p, j, lds, seq_len, tid, wave, lane); else { if (PROBE_MASK & 512) ret_intra_phase(p, j, lds, tid, wave, lane, true); ret_intra_phase(p, j, lds, tid, wave, lane, false); }
                } else if (step == 3) {
                    if (even) { mlstm_out_phase(p, j, lds, seq_len, tid, wave); if (PROBE_MASK & 256) mlstm_out_phase(p, j, lds, seq_len, tid, wave); xcd_barrier(bar); fin_ab_phase(p, j, wave, lane); if (PROBE_MASK & 1024) fin_ab_phase(p, j, wave, lane); } else break;
                } else {
                    act_fix_phase(p, layer, seq_len, tid);
                }
                xcd_barrier(bar);
                if (PROBE_MASK & 32) xcd_barrier(bar);
                }
            }
        }
    }
    { RELOAD_PARAMS(); int tid = tid0; asm volatile("" : "+v"(tid)); const int lane = tid & 63, wave = __builtin_amdgcn_readfirstlane(tid >> 6); chunk_start_phase(p, 2, 0, 1, wave, lane); }
}

extern "C" void kernel_launch(void* const* d_in, const int* in_sizes, int n_in, void* d_out, int out_size, void* d_ws, size_t ws_size, hipStream_t stream) {
    static int grid = 0;
    if (grid == 0) {
        if (n_in != 19 || out_size != TOT_ROWS * DM || ws_size < WS_CTL + CTL_BYTES) { fprintf(stderr, "kernel_launch: unexpected shapes / workspace (%d inputs, out %d, ws %zu)\n", n_in, out_size, ws_size); grid = -1; return; }
        int dev = 0, cus = 0, per_cu = 0;
        hipGetDevice(&dev); hipDeviceGetAttribute(&cus, hipDeviceAttributeMultiprocessorCount, dev);
        if (hipFuncSetAttribute((const void*)mega_fwd, hipFuncAttributeMaxDynamicSharedMemorySize, LDS_BYTES) != hipSuccess) { fprintf(stderr, "kernel_launch: hipFuncSetAttribute failed\n"); grid = -1; return; }
        hipOccupancyMaxActiveBlocksPerMultiprocessor(&per_cu, (const void*)mega_fwd, NTHREADS, LDS_BYTES);
        (void)hipGetLastError();
        if (per_cu < 1) per_cu = 1;
        grid = cus;
        if (grid > 256) grid = 256;
    }
    if (grid < 0) return;
    Params p{};
    for (int i = 0; i < 19; ++i) p.in[i] = (const float*)d_in[i];
    p.out = (float*)d_out; p.ws = (unsigned char*)d_ws;
    void* args[] = {&p};
    if (hipMemsetAsync((char*)d_ws + WS_CTL, 0, CTL_BYTES, stream) != hipSuccess) { fprintf(stderr, "kernel_launch: memset failed\n"); return; }
    hipError_t e = hipLaunchCooperativeKernel((const void*)mega_fwd, dim3(grid), dim3(NTHREADS), args, LDS_BYTES, stream);
    if (e != hipSuccess) fprintf(stderr, "cooperative launch failed: %s (grid %d)\n", hipGetErrorString(e), grid);
}
```

```cpp
#include <hip/hip_runtime.h>
#include <hip/hip_cooperative_groups.h>
#include <cstdio>
#include <cstdint>
namespace cg = cooperative_groups;
#ifndef PROBE_MASK
#define PROBE_MASK 0
#endif
#ifndef PROBE_VAR
#define PROBE_VAR 0
#endif
namespace pg8 {
#define PG8_LAS __attribute__((address_space(3)))
typedef unsigned short bf16_t;
typedef short bf16x8 __attribute__((ext_vector_type(8)));
typedef float f32x4 __attribute__((ext_vector_type(4)));
typedef unsigned u32x4 __attribute__((ext_vector_type(4)));
constexpr int BM = 256, BK = 64, HALF = 128, HTB = HALF * BK * 2  , STAGE_BYTES = 8 * HTB, NXCD = 8, WGM = 2;

__host__ __device__ __forceinline__ int lds_byte(int r, int c) { const int st = (r >> 4) * 2 + (c >> 5), rr = r & 15, cc = c & 31, ob = rr * 64 + cc * 2; return st * 1024 + (ob ^ (((ob >> 9) & 1) << 5)); }
__host__ __device__ __forceinline__ void stage_rc(int b, int& R, int& C) { const int st = b / 1024, sb = b % 1024, swz = sb ^ (((sb >> 9) & 1) << 5); R = (st >> 1) * 16 + swz / 64; C = (st & 1) * 32 + (swz % 64) / 2; }
__host__ __device__ __forceinline__ int perm32(int rho) { const int n = rho >> 4, i = rho & 15; return 8 * (i >> 2) + 4 * n + (i & 3); }

struct Unit { int pm, pn; };
struct Gemm { const bf16_t* A; const bf16_t* Bt; int M, N, K; };

struct StaticOrder {
    int nM, nN, nwg, G, c;
    __host__ __device__ void init(int M, int N, int G_, int c_) { nM = M / BM; nN = N / BM; nwg = nM * nN; G = G_; c = c_; }
    __host__ __device__ bool next(int i, Unit& u) const {
        const long L = (long)i * G + c; if (L >= nwg) return false;
        int wgid = (int)L; { const int q = nwg / NXCD, r = nwg % NXCD, xcd = wgid % NXCD, off = wgid / NXCD; wgid = (xcd < r ? xcd * (q + 1) : r * (q + 1) + (xcd - r) * q) + off; }
        const int nig = WGM * nN, gid = wgid / nig, fm = gid * WGM, gsz = (nM - fm) < WGM ? (nM - fm) : WGM;
        u.pm = fm + ((wgid % nig) % gsz); u.pn = (wgid % nig) / gsz; return true;
    }
    __device__ __forceinline__ void a_ready(const Unit&) const {}
    __device__ __forceinline__ void done(const Unit&) const {}
};

template <class Epi, class Sched, bool ALIGN_EPI = false, bool SP2 = false>
__device__ __forceinline__ void gemm_phase(PG8_LAS unsigned char* lds, const Gemm g, const Sched& S, const Epi& E) {
    int tid_o = threadIdx.x; asm volatile("" : "+v"(tid_o)); const int tid = tid_o, wid = __builtin_amdgcn_readfirstlane(tid >> 6), lane = tid & 63, wr = wid >> 2, wc = wid & 3, fr = lane & 15, fq = lane >> 4;
    const int K = g.K, nt = K / BK;
    unsigned voffA[2], voffB[2];
#pragma unroll
    for (int i = 0; i < 2; ++i) { int R, C; stage_rc(tid * 16 + i * 8192, R, C); const int Rb = Epi::PERM ? ((R & ~31) + perm32(R & 31)) : R;
        voffA[i] = (unsigned)(R * K + C) * 2u; voffB[i] = (unsigned)(Rb * K + C) * 2u; }
    const size_t kstep = (size_t)(BK * 2);
    const size_t hstep = (size_t)HALF * K * 2;
    const size_t tstep = 2 * hstep;
    const unsigned ldsw = (unsigned)wid * 1024u;
    const int aoff = lds_byte(wr * 64 + fr, fq * 8), boff = lds_byte(wc * 32 + fr, fq * 8);
#define PG8_SA(b, h) (((b) * 2 + (h)) * HTB)
#define PG8_SB(b, h) ((4 + (b) * 2 + (h)) * HTB)
#define PG8_STAGE(bufoff, gbase, voff) do { _Pragma("unroll") for (int _i = 0; _i < 2; ++_i) \
        __builtin_amdgcn_global_load_lds((const unsigned*)((const char*)(gbase) + (voff)[_i]), (PG8_LAS unsigned*)(lds + (bufoff) + ldsw + _i * 8192), 16, 0, 0); } while (0)
#define PG8_LDA(dst, b, h) do { _Pragma("unroll") for (int m = 0; m < 4; ++m) _Pragma("unroll") for (int k = 0; k < 2; ++k) dst[m][k] = *(const PG8_LAS bf16x8*)(lds + PG8_SA(b, h) + aoff + m * 2048 + k * 1024); } while (0)
#define PG8_LDB(dst, b, h) do { _Pragma("unroll") for (int n = 0; n < 2; ++n) _Pragma("unroll") for (int k = 0; k < 2; ++k) dst[n][k] = *(const PG8_LAS bf16x8*)(lds + PG8_SB(b, h) + boff + n * 2048 + k * 1024); } while (0)
#define PG8_MMA(ai, bj, At, Bt) do { __builtin_amdgcn_s_setprio(1); _Pragma("unroll") for (int m = 0; m < 4; ++m) _Pragma("unroll") for (int n = 0; n < 2; ++n) _Pragma("unroll") for (int k = 0; k < 2; ++k) \
        acc[ai][bj][m][n] = __builtin_amdgcn_mfma_f32_16x16x32_bf16(Bt[n][k], At[m][k], acc[ai][bj][m][n], 0, 0, 0); __builtin_amdgcn_s_setprio(0); } while (0)
#define PG8_WAIT_V(n) asm volatile("s_waitcnt vmcnt(" #n ")" ::: "memory")
#define PG8_WAIT_L(n) asm volatile("s_waitcnt lgkmcnt(" #n ")" ::: "memory")
#define PG8_BAR __builtin_amdgcn_s_barrier()
#define PG8_SCHED __builtin_amdgcn_sched_barrier(0)
    Unit cur, nxt; int ui = 0;
    if (!S.next(0, cur)) return;
    f32x4 acc[2][2][4][2];
    E.init(acc, cur, wr, wc, fr, fq);
    bf16x8 At[4][2], B0[2][2], B1[2][2];
    const char* cA = (const char*)g.A + (size_t)cur.pm * tstep; const char* cB = (const char*)g.Bt + (size_t)cur.pn * tstep;
    S.a_ready(cur);
    if constexpr (SP2) {
        PG8_STAGE(PG8_SB(0, 0), cB, voffB); PG8_STAGE(PG8_SB(0, 1), cB + hstep, voffB); PG8_STAGE(PG8_SA(0, 0), cA, voffA); PG8_STAGE(PG8_SA(0, 1), cA + hstep, voffA);
        if (wr == 1) PG8_BAR;
        PG8_WAIT_V(2); PG8_BAR;
        PG8_STAGE(PG8_SB(1, 0), cB + kstep, voffB); PG8_STAGE(PG8_SA(1, 0), cA + kstep, voffA); PG8_STAGE(PG8_SB(1, 1), cB + hstep + kstep, voffB);
        PG8_WAIT_V(6); PG8_BAR;
    } else {
        PG8_STAGE(PG8_SB(0, 0), cB, voffB); PG8_STAGE(PG8_SA(0, 0), cA, voffA); PG8_STAGE(PG8_SB(0, 1), cB + hstep, voffB); PG8_STAGE(PG8_SA(0, 1), cA + hstep, voffA);
        if (wr == 1) PG8_BAR;
        PG8_WAIT_V(4); PG8_BAR;
        PG8_STAGE(PG8_SB(1, 0), cB + kstep, voffB); PG8_STAGE(PG8_SA(1, 0), cA + kstep, voffA); PG8_STAGE(PG8_SB(1, 1), cB + hstep + kstep, voffB);
        PG8_WAIT_V(6); PG8_BAR;
    }
    for (;;) {
        const bool has_next = S.next(ui + 1, nxt);
        const char* nA = has_next ? (const char*)g.A + (size_t)nxt.pm * tstep : cA; const char* nB = has_next ? (const char*)g.Bt + (size_t)nxt.pn * tstep : cB;
        for (int t = 0; t < nt; t += 2) {
            const bool last = (t == nt - 2);
            const char* a1 = cA + (size_t)(t + 1) * kstep;
            const char* a2 = last ? nA : cA + (size_t)(t + 2) * kstep; const char* b2 = last ? nB : cB + (size_t)(t + 2) * kstep;
            const char* a3 = a2 + kstep; const char* b3 = b2 + kstep;
            if (last && has_next) S.a_ready(nxt);
            if constexpr (SP2) {
            PG8_LDB(B0, 0, 0); PG8_LDB(B1, 0, 1); PG8_SCHED; PG8_LDA(At, 0, 0); PG8_STAGE(PG8_SA(1, 1), a1 + hstep, voffA);
            PG8_WAIT_V(8); PG8_WAIT_L(0); PG8_BAR; PG8_MMA(0, 0, At, B0); PG8_MMA(0, 1, At, B1); PG8_BAR; PG8_SCHED;
            PG8_LDA(At, 0, 1); PG8_STAGE(PG8_SB(0, 0), b2, voffB); PG8_STAGE(PG8_SB(0, 1), b2 + hstep, voffB); PG8_STAGE(PG8_SA(0, 0), a2, voffA);
            PG8_WAIT_V(8); PG8_WAIT_L(0); PG8_BAR; PG8_MMA(1, 0, At, B0); PG8_MMA(1, 1, At, B1); PG8_BAR; PG8_SCHED;
            PG8_LDB(B0, 1, 0); PG8_LDB(B1, 1, 1); PG8_SCHED; PG8_LDA(At, 1, 0); PG8_STAGE(PG8_SA(0, 1), a2 + hstep, voffA);
            PG8_WAIT_V(8); PG8_WAIT_L(0); PG8_BAR; PG8_MMA(0, 0, At, B0); PG8_MMA(0, 1, At, B1); PG8_BAR; PG8_SCHED;
            PG8_LDA(At, 1, 1); PG8_STAGE(PG8_SB(1, 0), b3, voffB); PG8_STAGE(PG8_SB(1, 1), b3 + hstep, voffB); PG8_STAGE(PG8_SA(1, 0), a3, voffA);
            PG8_WAIT_V(8); PG8_WAIT_L(0); PG8_BAR; PG8_MMA(1, 0, At, B0); PG8_MMA(1, 1, At, B1); PG8_BAR; PG8_SCHED;
            } else {
            PG8_LDB(B0, 0, 0); PG8_SCHED; PG8_LDA(At, 0, 0); PG8_STAGE(PG8_SA(1, 1), a1 + hstep, voffA);
            PG8_WAIT_L(8); PG8_BAR; PG8_WAIT_L(0); PG8_MMA(0, 0, At, B0); PG8_BAR; PG8_SCHED;
            PG8_LDB(B1, 0, 1); PG8_STAGE(PG8_SB(0, 0), b2, voffB);
            PG8_BAR; PG8_WAIT_L(0); PG8_MMA(0, 1, At, B1); PG8_BAR;
            PG8_LDA(At, 0, 1); PG8_STAGE(PG8_SA(0, 0), a2, voffA);
            PG8_BAR; PG8_WAIT_L(0); PG8_MMA(1, 0, At, B0); PG8_BAR; PG8_SCHED;
            PG8_STAGE(PG8_SB(0, 1), b2 + hstep, voffB);
            PG8_WAIT_V(6); PG8_BAR; PG8_MMA(1, 1, At, B1); PG8_BAR;
            PG8_LDB(B0, 1, 0); PG8_SCHED; PG8_LDA(At, 1, 0); PG8_STAGE(PG8_SA(0, 1), a2 + hstep, voffA);
            PG8_WAIT_L(8); PG8_BAR; PG8_WAIT_L(0); PG8_MMA(0, 0, At, B0); PG8_BAR; PG8_SCHED;
            PG8_LDB(B1, 1, 1); PG8_STAGE(PG8_SB(1, 0), b3, voffB);
            PG8_BAR; PG8_WAIT_L(0); PG8_MMA(0, 1, At, B1); PG8_BAR;
            PG8_LDA(At, 1, 1); PG8_STAGE(PG8_SA(1, 0), a3, voffA);
            PG8_BAR; PG8_WAIT_L(0); PG8_MMA(1, 0, At, B0); PG8_BAR; PG8_SCHED;
            PG8_STAGE(PG8_SB(1, 1), b3 + hstep, voffB);
            PG8_WAIT_V(6); PG8_BAR; PG8_MMA(1, 1, At, B1); PG8_BAR;
            }
        }
        if constexpr (ALIGN_EPI) { if (wr == 0) PG8_BAR; }
        if constexpr (!Epi::AFTER_DRAIN) { E(acc, cur, wr, wc, fr, fq); S.done(cur); }
        if (!has_next) break;
        E.init(acc, nxt, wr, wc, fr, fq);
        cur = nxt; cA = nA; cB = nB; ++ui;
        if constexpr (ALIGN_EPI) { if (wr == 1) PG8_BAR; }
    }
    PG8_WAIT_V(0);
    if constexpr (!ALIGN_EPI) { if (wr == 0) PG8_BAR; }
    PG8_BAR;
    if constexpr (Epi::AFTER_DRAIN) { E.fused(acc, cur, wr, wc, fr, fq, lds, wid, lane); S.done(cur); }
#undef PG8_SA
#undef PG8_SB
#undef PG8_STAGE
#undef PG8_LDA
#undef PG8_LDB
#undef PG8_MMA
#undef PG8_WAIT_V
#undef PG8_WAIT_L
#undef PG8_BAR
#undef PG8_SCHED
}
}
#define LAS __attribute__((address_space(3)))
typedef unsigned short bf16_t;
typedef short bf16x8 __attribute__((ext_vector_type(8)));
typedef short s16x4 __attribute__((ext_vector_type(4)));
typedef float f32x4 __attribute__((ext_vector_type(4)));
typedef float f32x16 __attribute__((ext_vector_type(16)));
typedef unsigned u32x4 __attribute__((ext_vector_type(4)));
typedef unsigned u32x2 __attribute__((ext_vector_type(2)));
typedef float f32x2_t __attribute__((ext_vector_type(2)));
typedef __bf16 bf16x2_t __attribute__((ext_vector_type(2)));

constexpr int NTHREADS = 512;
constexpr int LDS_BYTES = 147456;
constexpr int DM = 1024;
constexpr int CH_ROWS = 16384;
constexpr int TOT_ROWS = 49152;
constexpr float EPS = 1e-6f;
constexpr float LOG2E = 1.4426950408889634f;

constexpr size_t MiB = 1u << 20;
constexpr size_t W_ABIN = 0, W_ABIN_SZ = (size_t)3072 * 1024 * 2;
constexpr size_t W_ABOUT = W_ABIN + 2 * W_ABIN_SZ, W_ABOUT_SZ = (size_t)1024 * 1024 * 2;
constexpr size_t W_RETIN = W_ABOUT + 2 * W_ABOUT_SZ, W_RETIN_SZ = (size_t)6144 * 1024 * 2;
constexpr size_t W_RETOUT = W_RETIN + 2 * W_RETIN_SZ, W_RETOUT_SZ = (size_t)1024 * 2048 * 2;
constexpr size_t W_UP = W_RETOUT + 2 * W_RETOUT_SZ, W_UP_SZ = (size_t)5632 * 1024 * 2;
constexpr size_t W_DOWN = W_UP + 4 * W_UP_SZ, W_DOWN_SZ = (size_t)1024 * 2816 * 2;
static_assert(W_DOWN + 4 * W_DOWN_SZ <= 120 * MiB, "weights");
constexpr size_t WS_XB = 120 * MiB;
constexpr size_t WS_BIG1 = 152 * MiB;
constexpr size_t WS_BIG2 = 344 * MiB;
constexpr size_t WS_SSQ = 472 * MiB;
constexpr size_t WS_GATES = 475 * MiB;
constexpr size_t WS_ROPE = 476 * MiB;
constexpr size_t WS_END = 486 * MiB;
constexpr int RA_ROW = 0, RA_COL = 128 * 16, RR_ROW = RA_COL + 64 * 16, RR_COL = RR_ROW + 128 * 64, ROPE_N = RR_COL + 64 * 64;
constexpr size_t WS_CTL = 486 * MiB, CTL_BYTES = 65536;

struct Params { const float* in[19]; float* out; unsigned char* ws; };

__device__ __forceinline__ unsigned cvtpk(float lo, float hi) { f32x2_t v = {lo, hi}; bf16x2_t b = __builtin_convertvector(v, bf16x2_t); return __builtin_bit_cast(unsigned, b); }
__device__ __forceinline__ bf16_t f2bf(float f) { return (bf16_t)(cvtpk(f, 0.f) & 0xffffu); }
__device__ __forceinline__ float bf2f(bf16_t b) { return __uint_as_float((unsigned)b << 16); }
__device__ __forceinline__ float bflo(unsigned u) { return __uint_as_float(u << 16); }
__device__ __forceinline__ float bfhi(unsigned u) { return __uint_as_float(u & 0xffff0000u); }
__device__ __forceinline__ float wave_sum(float v) {
#pragma unroll
    for (int o = 1; o < 64; o <<= 1) v += __shfl_xor(v, o);
    return v;
}
__device__ __forceinline__ float sigmoidf_(float x) { return 1.f / (1.f + __expf(-x)); }
__device__ __forceinline__ float logsigmoidf_(float x) { return fminf(x, 0.f) - log1pf(__expf(-fabsf(x))); }

__device__ __forceinline__ bf16x8 lds_rows(const LAS bf16_t* base, int ld, int row0, int k0, int lane) {
    return *(const LAS bf16x8*)(base + (row0 + (lane & 31)) * ld + k0 + 8 * (lane >> 5));
}
__device__ __forceinline__ s16x4 tr16(const LAS bf16_t* p) {
    return __builtin_bit_cast(s16x4, __builtin_amdgcn_ds_read_tr16_b64_v4i16((LAS s16x4*)p));
}
__device__ __forceinline__ bf16x8 lds_tr(const LAS bf16_t* base, int ld, int k0, int c0, int lane) {
#ifdef SLOW_TR
    bf16x8 o;
#pragma unroll
    for (int j = 0; j < 8; ++j) o[j] = (short)base[(k0 + 8 * (lane >> 5) + j) * ld + c0 + (lane & 31)];
    return o;
#else
    const int g = lane >> 4, i = lane & 15, q = i >> 2, p = i & 3, h = g >> 1;
    const LAS bf16_t* a = base + (k0 + 8 * h + q) * ld + c0 + 16 * (g & 1) + 4 * p;
    const s16x4 lo = tr16(a), hi = tr16(a + 4 * ld);
    return (bf16x8){lo[0], lo[1], lo[2], lo[3], hi[0], hi[1], hi[2], hi[3]};
#endif
}
__device__ __forceinline__ bf16x8 lds_tr_perm(const LAS bf16_t* base, int ld, int k0, int c0, int lane) {
#ifdef SLOW_TR
    bf16x8 o;
#pragma unroll
    for (int j = 0; j < 8; ++j) o[j] = (short)base[(k0 + 8 * (j >> 2) + 4 * (lane >> 5) + (j & 3)) * ld + c0 + (lane & 31)];
    return o;
#else
    const int g = lane >> 4, i = lane & 15, q = i >> 2, p = i & 3, h = g >> 1;
    const LAS bf16_t* a = base + (k0 + 4 * h + q) * ld + c0 + 16 * (g & 1) + 4 * p;
    const s16x4 lo = tr16(a), hi = tr16(a + 8 * ld);
    return (bf16x8){lo[0], lo[1], lo[2], lo[3], hi[0], hi[1], hi[2], hi[3]};
#endif
}
__device__ __forceinline__ f32x16 mfma32(bf16x8 a, bf16x8 b, f32x16 c) { return __builtin_amdgcn_mfma_f32_32x32x16_bf16(a, b, c, 0, 0, 0); }
__device__ __forceinline__ bf16x8 pack8(const f32x16& a, int s) {
    u32x4 w; w.x = cvtpk(a[8 * s + 0], a[8 * s + 1]); w.y = cvtpk(a[8 * s + 2], a[8 * s + 3]); w.z = cvtpk(a[8 * s + 4], a[8 * s + 5]); w.w = cvtpk(a[8 * s + 6], a[8 * s + 7]);
    return __builtin_bit_cast(bf16x8, w);
}
__device__ __forceinline__ int accrow(int reg, int h) { return (reg & 3) + 8 * (reg >> 2) + 4 * h; }
__device__ __forceinline__ float gelu_as(float v) {
    const float av = fabsf(v), t = __builtin_amdgcn_rcpf(av * 0.2316418882f + 1.0f);
    float q = t * 0.5307027145f + (-0.7265760135f); q = q * t + 0.7107068705f; q = q * t + (-0.142248368f); q = q * t + 0.127414796f; q = q * t;
    const float e = __builtin_amdgcn_exp2f((v * v) * (-0.72134752044f));
    const float m = v * (q * e);
    return v < 0.f ? m : v - m;
}
#define XB_TMO      128
#define XB_XCNT(j)  (256  + 64 * (j))
#define XB_XSUB(j)  (1280 + 64 * (j))
#define XB_XGEN(j)  (2304 + 64 * (j))
#define XB_TOP      3328
#define XB_TOPGEN   3392
#define XCD_BAR_WORDS 3456
#define XB_SPIN_CAP (1u << 18)

__device__ __forceinline__ unsigned xb_ld(unsigned* p)              { return __hip_atomic_load(p, __ATOMIC_RELAXED, __HIP_MEMORY_SCOPE_AGENT); }
__device__ __forceinline__ unsigned xb_add(unsigned* p, unsigned v) { return __hip_atomic_fetch_add(p, v, __ATOMIC_RELAXED, __HIP_MEMORY_SCOPE_AGENT); }
__device__ __forceinline__ unsigned xb_xcc_id() { return (unsigned)__builtin_amdgcn_s_getreg((3 << 11) | 20) & 0xFu; }
#define XB_SPIN(cond, bar) do { unsigned _sp = 0; while (cond) { __builtin_amdgcn_s_sleep(0); \
    if ((++_sp & 255u) == 0u) { if (xb_ld(&(bar)[XB_TMO])) break; if (_sp > XB_SPIN_CAP) { atomicAdd(&(bar)[XB_TMO], 1u); break; } } } } while (0)

struct XcdBarrier {
    unsigned* bar; unsigned x;
    volatile LAS unsigned* st;
};

__device__ __forceinline__ XcdBarrier xcd_barrier_post(unsigned* bar, volatile LAS unsigned* st) {
    XcdBarrier b; b.bar = bar; b.x = xb_xcc_id(); b.st = st;
    if (threadIdx.x == 0) (void)xb_add(&bar[XB_XCNT(b.x)], 1u);
    return b;
}
__device__ __forceinline__ void xcd_barrier_complete(unsigned* bar, unsigned x, unsigned& nloc, unsigned& nx) {
    const unsigned G = gridDim.x * gridDim.y * gridDim.z;
    unsigned sum, cnt, mine, sp = 0u;
    for (;;) {
        sum = 0u; cnt = 0u; mine = 0u;
#pragma unroll
        for (unsigned j = 0; j < 16; ++j) { const unsigned c = xb_ld(&bar[XB_XCNT(j)]); sum += c; cnt += (c > 0u) ? 1u : 0u; mine = (j == x) ? c : mine; }
        if (sum == G) break;
        __builtin_amdgcn_s_sleep(1);
        if ((++sp & 255u) == 0u) { if (xb_ld(&bar[XB_TMO])) break; if (sp > XB_SPIN_CAP) { atomicAdd(&bar[XB_TMO], 1u); break; } }
    }
    nloc = mine > 0u ? mine : 1u; nx = cnt > 0u ? cnt : 1u;
}

__device__ __forceinline__ void xcd_barrier(const XcdBarrier& b) {
    asm volatile("s_waitcnt vmcnt(0)" ::: "memory");
    __syncthreads();
    if (threadIdx.x == 0) {
        unsigned* bar = b.bar;
        __builtin_amdgcn_s_waitcnt(0);
        unsigned nloc = b.st[0], nx = b.st[1];
        if (nloc == 0u) { xcd_barrier_complete(bar, b.x, nloc, nx); b.st[0] = nloc; b.st[1] = nx; }
        const unsigned old = xb_add(&bar[XB_XSUB(b.x)], 1u);
        const unsigned gen = old / nloc;
        if (old + 1u == (gen + 1u) * nloc) {
            __builtin_amdgcn_fence(__ATOMIC_RELEASE, "agent");
            asm volatile("s_waitcnt vmcnt(0)" ::: "memory");
            const unsigned og = xb_add(&bar[XB_TOP], 1u);
            const unsigned tg = og / nx;
            if (og + 1u == (tg + 1u) * nx) xb_add(&bar[XB_TOPGEN], 1u);
            else XB_SPIN(xb_ld(&bar[XB_TOPGEN]) == tg, bar);
            __builtin_amdgcn_fence(__ATOMIC_ACQUIRE, "agent");
            xb_add(&bar[XB_XGEN(b.x)], 1u);
            asm volatile("s_waitcnt vmcnt(0)" ::: "memory");
        } else {
            XB_SPIN(xb_ld(&bar[XB_XGEN(b.x)]) == gen, bar);
            __builtin_amdgcn_fence(__ATOMIC_ACQUIRE, "agent");
            asm volatile("s_waitcnt vmcnt(0)" ::: "memory");
        }
    }
    __syncthreads();
}
struct EpiF {
    bf16_t* O; int ldo;
    const float* ssq;
    float* gates;
    bf16_t* qt; int colsub;
    bf16_t* act; bf16_t* sb; const float* cw; const float* cb;
    const float* qn; const float* kn; const float* cosa; const float* sina;
    const float* cosr; const float* sinr; int seqmask;
    float* x; bf16_t* xb; float* ssq_out;
};
template <int MODE  > struct EpiT : EpiF {
    static constexpr bool PERM = true, AFTER_DRAIN = false;
    static constexpr int mode = MODE;
    __device__ __forceinline__ void init(pg8::f32x4 (&acc)[2][2][4][2], const pg8::Unit& u, int wr, int wc, int fr, int fq) const {
        if (false) {
            const int rowb = u.pm * 256 + wr * 64 + fr, colb = u.pn * 256 + wc * 32 + 8 * fq;
#pragma unroll
            for (int ai = 0; ai < 2; ++ai)
#pragma unroll
                for (int m = 0; m < 4; ++m) {
                    const float* xr = x + (size_t)(rowb + ai * 128 + m * 16) * DM + colb;
#pragma unroll
                    for (int bj = 0; bj < 2; ++bj) { acc[ai][bj][m][0] = *(const f32x4*)(xr + bj * 128); acc[ai][bj][m][1] = *(const f32x4*)(xr + bj * 128 + 4); }
                }
        } else {
#pragma unroll
            for (int ai = 0; ai < 2; ++ai)
#pragma unroll
                for (int bj = 0; bj < 2; ++bj)
#pragma unroll
                    for (int m = 0; m < 4; ++m) { acc[ai][bj][m][0] = (f32x4){0.f, 0.f, 0.f, 0.f}; acc[ai][bj][m][1] = (f32x4){0.f, 0.f, 0.f, 0.f}; }
        }
    }
    __device__ __forceinline__ void operator()(const pg8::f32x4 (&acc)[2][2][4][2], const pg8::Unit& u, int wr, int wc, int fr, int fq) const {
        const int rowb = u.pm * 256 + wr * 64 + fr;
        const int colb = u.pn * 256 + wc * 32 + 8 * fq;
        if (mode == 3) {
#pragma unroll
            for (int ai = 0; ai < 2; ++ai)
#pragma unroll
                for (int m = 0; m < 4; ++m) {
                    const int row = rowb + ai * 128 + m * 16;
                    bf16_t* xbr = xb + (size_t)row * DM + colb;
                    float ss = 0.f;
#pragma unroll
                    for (int bj = 0; bj < 2; ++bj) {
                        const u32x4 xo = *(const u32x4*)(xbr + bj * 128);
                        f32x4 v0 = acc[ai][bj][m][0], v1 = acc[ai][bj][m][1];
                        v0[0] += bflo(xo.x); v0[1] += bfhi(xo.x); v0[2] += bflo(xo.y); v0[3] += bfhi(xo.y);
                        v1[0] += bflo(xo.z); v1[1] += bfhi(xo.z); v1[2] += bflo(xo.w); v1[3] += bfhi(xo.w);
                        if (x) {
                            float* xr = x + (size_t)row * DM + colb + bj * 128;
                            *(f32x4*)xr = v0; *(f32x4*)(xr + 4) = v1;
                        } else {
                            u32x4 w; w.x = cvtpk(v0[0], v0[1]); w.y = cvtpk(v0[2], v0[3]); w.z = cvtpk(v1[0], v1[1]); w.w = cvtpk(v1[2], v1[3]);
                            *(u32x4*)(xbr + bj * 128) = w;
                            v0[0] = bflo(w.x); v0[1] = bfhi(w.x); v0[2] = bflo(w.y); v0[3] = bfhi(w.y); v1[0] = bflo(w.z); v1[1] = bfhi(w.z); v1[2] = bflo(w.w); v1[3] = bfhi(w.w);
                        }
                        ss += (v0[0] * v0[0] + v0[1] * v0[1]) + (v0[2] * v0[2] + v0[3] * v0[3]) + (v1[0] * v1[0] + v1[1] * v1[1]) + (v1[2] * v1[2] + v1[3] * v1[3]);
                    }
                    ss += __shfl_xor(ss, 16); ss += __shfl_xor(ss, 32);
                    if (fq == 0) ssq_out[(size_t)row * 16 + u.pn * 4 + wc] = ss;
                }
            return;
        }
        if (mode == 2) {
            const int lane16 = fr;
            const int ch0 = u.pn * 128 + wc * 32 + 8 * fq;
            f32x4 kw0[2], kw1[2], kw2[2], kb[2];
#pragma unroll
            for (int n = 0; n < 2; ++n) { kw0[n] = *(const f32x4*)(cw + ch0 + 4 * n); kw1[n] = *(const f32x4*)(cw + 2816 + ch0 + 4 * n); kw2[n] = *(const f32x4*)(cw + 5632 + ch0 + 4 * n); kb[n] = *(const f32x4*)(cb + ch0 + 4 * n); }
            float rsa[2][4];
            {
                f32x4 sv[2][4];
#pragma unroll
                for (int ai = 0; ai < 2; ++ai)
#pragma unroll
                    for (int m = 0; m < 4; ++m) sv[ai][m] = *(const f32x4*)(ssq + (size_t)(rowb + ai * 128 + m * 16) * 16 + 4 * fq);
#pragma unroll
                for (int ai = 0; ai < 2; ++ai)
#pragma unroll
                    for (int m = 0; m < 4; ++m) {
                        float ss = (sv[ai][m][0] + sv[ai][m][1]) + (sv[ai][m][2] + sv[ai][m][3]);
                        ss += __shfl_xor(ss, 16); ss += __shfl_xor(ss, 32);
                        rsa[ai][m] = rsqrtf(ss * (1.0f / DM) + EPS);
                    }
            }
#pragma unroll
            for (int ai = 0; ai < 2; ++ai) {
                float rs[4];
#pragma unroll
                for (int m = 0; m < 4; ++m) rs[m] = rsa[ai][m];
#pragma unroll
                for (int m = 0; m < 4; ++m) {
                    const int row = rowb + ai * 128 + m * 16;
                    const int mp = (m > 0) ? m - 1 : 0, mn = (m < 3) ? m + 1 : 3;
                    u32x4 wo, wu, wg; unsigned wv[4], uvv[4], gvv[4];
#pragma unroll
                    for (int n = 0; n < 2; ++n) {
                        const f32x4 us = acc[ai][0][m][n] * rs[m];
                        float y[4];
#pragma unroll
                        for (int jj = 0; jj < 4; ++jj) {
                            const float gc = acc[ai][1][m][n][jj] * rs[m];
                            const float tp = (lane16 == 15) ? acc[ai][1][mp][n][jj] * rs[mp] : gc, tn = (lane16 == 0) ? acc[ai][1][mn][n][jj] * rs[mn] : gc;
                            const float gprev = __int_as_float(__builtin_amdgcn_update_dpp(0, __float_as_int(tp), 0x121, 0xf, 0xf, false));
                            const float gnext = __int_as_float(__builtin_amdgcn_update_dpp(0, __float_as_int(tn), 0x12f, 0xf, 0xf, false));
                            const float yy = gprev * kw0[n][jj] + gc * kw1[n][jj] + gnext * kw2[n][jj] + kb[n][jj];
                            y[jj] = gelu_as(yy) * us[jj];
                        }
                        wv[2 * n] = cvtpk(y[0], y[1]); wv[2 * n + 1] = cvtpk(y[2], y[3]);
                        uvv[2 * n] = cvtpk(us[0], us[1]); uvv[2 * n + 1] = cvtpk(us[2], us[3]);
                        { const f32x4 gq = acc[ai][1][m][n] * rs[m]; gvv[2 * n] = cvtpk(gq[0], gq[1]); gvv[2 * n + 1] = cvtpk(gq[2], gq[3]); }
                    }
                    wo.x = wv[0]; wo.y = wv[1]; wo.z = wv[2]; wo.w = wv[3];
                    *(u32x4*)(act + (size_t)row * 2816 + ch0) = wo;
                    const int r64 = (m * 16 + lane16);
                    if (r64 < 2 || r64 >= 62) {
                        wu.x = uvv[0]; wu.y = uvv[1]; wu.z = uvv[2]; wu.w = uvv[3]; wg.x = gvv[0]; wg.y = gvv[1]; wg.z = gvv[2]; wg.w = gvv[3];
                        bf16_t* sbr = sb + ((size_t)(row >> 6) * 4 + ((r64 < 2) ? r64 + 2 : r64 - 62)) * 5632 + ch0;
                        *(u32x4*)sbr = wu; *(u32x4*)(sbr + 2816) = wg;
                    }
                }
            }
            return;
        }
        float rsv[2][4];
        {
            f32x4 sv[2][4];
#pragma unroll
            for (int ai = 0; ai < 2; ++ai)
#pragma unroll
                for (int m = 0; m < 4; ++m) sv[ai][m] = *(const f32x4*)(ssq + (size_t)(rowb + ai * 128 + m * 16) * 16 + 4 * fq);
#pragma unroll
            for (int ai = 0; ai < 2; ++ai)
#pragma unroll
                for (int m = 0; m < 4; ++m) {
                    float ss = (sv[ai][m][0] + sv[ai][m][1]) + (sv[ai][m][2] + sv[ai][m][3]);
                    ss += __shfl_xor(ss, 16); ss += __shfl_xor(ss, 32);
                    rsv[ai][m] = rsqrtf(ss * (1.0f / DM) + EPS);
                }
        }
#pragma unroll
        for (int ai = 0; ai < 2; ++ai)
#pragma unroll
            for (int m = 0; m < 4; ++m) {
                const int row = rowb + ai * 128 + m * 16;
                const float rs = rsv[ai][m];
                f32x4 v[2][2];
#pragma unroll
                for (int bj = 0; bj < 2; ++bj) { v[bj][0] = acc[ai][bj][m][0] * rs; v[bj][1] = acc[ai][bj][m][1] * rs; }
                if (mode == 1 && u.pn < 8) {
                    const int pos = row & seqmask; const int i0 = wc * 32 + 8 * fq;
#pragma unroll
                    for (int n = 0; n < 2; ++n) {
                        const int ti = ((wc < 2) ? RR_ROW + (pos >> 6) * 64 + i0 : RR_COL + (pos & 63) * 64 + (i0 - 64)) + 4 * n;
                        const f32x4 c = *(const f32x4*)(cosr + ti), s = *(const f32x4*)(cosr + ROPE_N + ti);
                        const f32x4 x1 = v[0][n], x2 = v[1][n];
                        v[0][n] = x1 * c - x2 * s; v[1][n] = x2 * c + x1 * s;
                    }
                }
                if (mode == 0 && u.pn < 3) {
                    const int hh = 4 * u.pn + wc;
                    if (hh < 10) {
                        float ss = 0.f;
#pragma unroll
                        for (int bj = 0; bj < 2; ++bj)
#pragma unroll
                            for (int n = 0; n < 2; ++n) ss += (v[bj][n][0] * v[bj][n][0] + v[bj][n][1] * v[bj][n][1]) + (v[bj][n][2] * v[bj][n][2] + v[bj][n][3] * v[bj][n][3]);
                        ss += __shfl_xor(ss, 16); ss += __shfl_xor(ss, 32);
                        const float hrs = rsqrtf(ss * (1.0f / 64.0f) + EPS) * ((hh < 8) ? 0.125f * LOG2E : 1.0f);
                        const float* gp = ((hh < 8) ? qn : kn) + 8 * fq;
                        const int pos = row & seqmask;
#pragma unroll
                        for (int n = 0; n < 2; ++n) {
                            const f32x4 g1 = *(const f32x4*)(gp + 4 * n), g2 = *(const f32x4*)(gp + 32 + 4 * n);
                            const int ti = ((fq < 2) ? RA_ROW + (pos >> 6) * 16 + 8 * fq : RA_COL + (pos & 63) * 16 + 8 * (fq - 2)) + 4 * n;
                            const f32x4 c = *(const f32x4*)(cosa + ti), s = *(const f32x4*)(cosa + ROPE_N + ti);
                            const f32x4 y1 = v[0][n] * g1 * hrs, y2 = v[1][n] * g2 * hrs;
                            v[0][n] = y1 * c - y2 * s; v[1][n] = y2 * c + y1 * s;
                        }
                    }
                    bf16_t* orow = O + (size_t)row * ldo + u.pn * 256 + wc * 64 + 8 * fq;
#pragma unroll
                    for (int bj = 0; bj < 2; ++bj) {
                        u32x4 w; w.x = cvtpk(v[bj][0][0], v[bj][0][1]); w.y = cvtpk(v[bj][0][2], v[bj][0][3]); w.z = cvtpk(v[bj][1][0], v[bj][1][1]); w.w = cvtpk(v[bj][1][2], v[bj][1][3]);
                        *(u32x4*)(orow + bj * 32) = w;
                    }
                } else if (mode == 0 && u.pn == 11) {
                    if (wc == 0 && fq < 2) { float* g = gates + (size_t)row * 16 + 8 * fq; *(f32x4*)g = v[0][0]; *(f32x4*)(g + 4) = v[0][1]; }
                } else if (mode == 1 && u.pn < 4) {
                    const int cidx = row >> 7, l = row & 127;
#pragma unroll
                    for (int bj = 0; bj < 2; ++bj) {
                        const int d0 = bj * 128 + wc * 32 + 8 * fq;
                        bf16_t* dst = qt + ((((((size_t)cidx * 4 + u.pn) * 4 + (l >> 5)) * 16 + (d0 >> 4)) * 2 + ((d0 >> 3) & 1)) * 32 + (l & 31)) * 8;
                        u32x4 w; w.x = cvtpk(v[bj][0][0], v[bj][0][1]); w.y = cvtpk(v[bj][0][2], v[bj][0][3]); w.z = cvtpk(v[bj][1][0], v[bj][1][1]); w.w = cvtpk(v[bj][1][2], v[bj][1][3]);
                        *(u32x4*)dst = w;
                    }
                } else {
                    bf16_t* orow = O + (size_t)row * ldo + colb - colsub;
#pragma unroll
                    for (int bj = 0; bj < 2; ++bj) {
                        u32x4 w; w.x = cvtpk(v[bj][0][0], v[bj][0][1]); w.y = cvtpk(v[bj][0][2], v[bj][0][3]); w.z = cvtpk(v[bj][1][0], v[bj][1][1]); w.w = cvtpk(v[bj][1][2], v[bj][1][3]);
                        *(u32x4*)(orow + bj * 128) = w;
                    }
                }
            }
    }
};
struct WDesc { const float* W; int K, N; bf16_t* WT; const float* gain; int cs_lo, cs_hi; float cs; int perm_up, perm_ab; };
__device__ __forceinline__ void get_wdesc(const Params& p, int m, WDesc& d) {
    unsigned char* ws = p.ws;
    d.gain = nullptr; d.cs_lo = 0; d.cs_hi = 0; d.cs = 1.f; d.perm_up = 0; d.perm_ab = 0;
    if (m < 2) { const int j = m; d.W = p.in[5] + (size_t)j * 1024 * 2832; d.K = 1024; d.N = 2832; d.WT = (bf16_t*)(ws + W_ABIN + j * W_ABIN_SZ); d.gain = p.in[2] + (2 * j) * 1024; d.cs_lo = 1280; d.cs_hi = 1792; d.cs = 0.08838834764831845f; d.perm_ab = 1; }
    else if (m < 4) { const int j = m - 2; d.W = p.in[10] + (size_t)j * 1024 * 1024; d.K = 1024; d.N = 1024; d.WT = (bf16_t*)(ws + W_ABOUT + j * W_ABOUT_SZ); }
    else if (m < 6) { const int j = m - 4; d.W = p.in[11] + (size_t)j * 1024 * 6144; d.K = 1024; d.N = 6144; d.WT = (bf16_t*)(ws + W_RETIN + j * W_RETIN_SZ); d.gain = p.in[2] + (2 * j + 1) * 1024; d.cs_lo = 1024; d.cs_hi = 2048; d.cs = 0.0625f; }
    else if (m < 8) { const int j = m - 6; d.W = p.in[14] + (size_t)j * 2048 * 1024; d.K = 2048; d.N = 1024; d.WT = (bf16_t*)(ws + W_RETOUT + j * W_RETOUT_SZ); }
    else if (m < 12) { const int l = m - 8; d.W = p.in[15] + (size_t)l * 1024 * 5632; d.K = 1024; d.N = 5632; d.WT = (bf16_t*)(ws + W_UP + l * W_UP_SZ); d.gain = p.in[3] + l * 1024; d.perm_up = 1; }
    else { const int l = m - 12; d.W = p.in[18] + (size_t)l * 2816 * 1024; d.K = 2816; d.N = 1024; d.WT = (bf16_t*)(ws + W_DOWN + l * W_DOWN_SZ); }
}
__device__ __forceinline__ void transpose_item(const WDesc& d, LAS float* scr, int item, int lane) {
    const int nblk = (d.N + 31) / 32, kb = item / nblk, nb = item % nblk, k0 = 64 * kb, n0 = 32 * nb;
    const int nq = n0 + 4 * (lane & 7);
#pragma unroll
    for (int i = 0; i < 8; ++i) {
        const int kk = i * 8 + (lane >> 3);
        f32x4 v = {0.f, 0.f, 0.f, 0.f};
        if (nq < d.N) v = *(const f32x4*)(d.W + (size_t)(k0 + kk) * d.N + nq);
        if (d.gain) v = v * d.gain[k0 + kk];
        LAS float* sp = scr + kk * 33 + 4 * (lane & 7);
        sp[0] = v[0]; sp[1] = v[1]; sp[2] = v[2]; sp[3] = v[3];
    }
    asm volatile("s_waitcnt lgkmcnt(0)" ::: "memory");
    const int c = lane & 7;
#pragma unroll
    for (int j = 0; j < 4; ++j) { const int n = (lane >> 3) + 8 * j; const LAS float* s = scr + (8 * c) * 33 + n;
        const float sc = (n0 + n >= d.cs_lo && n0 + n < d.cs_hi) ? d.cs : 1.f;
        u32x4 o; o.x = cvtpk(s[0 * 33] * sc, s[1 * 33] * sc); o.y = cvtpk(s[2 * 33] * sc, s[3 * 33] * sc); o.z = cvtpk(s[4 * 33] * sc, s[5 * 33] * sc); o.w = cvtpk(s[6 * 33] * sc, s[7 * 33] * sc);
        int orow = n0 + n;
        if (d.perm_ab && orow < 768) { const int rem = orow & 255; orow = (orow & ~255) + 128 * ((rem >> 5) & 1) + 32 * (rem >> 6) + (rem & 31); }
        if (d.perm_up) { const int isg = orow >= 2816, chn = orow - (isg ? 2816 : 0); orow = (chn >> 7) * 256 + isg * 128 + (chn & 127); }
        *(u32x4*)(d.WT + (size_t)orow * d.K + k0 + 8 * c) = o; }
    asm volatile("s_waitcnt lgkmcnt(0)" ::: "memory");
}
__device__ __forceinline__ void sincos_d(double a, float& c, float& s) {
    const double INV_TWO_PI = 0.15915494309189533577, TWO_PI = 6.283185307179586476925;
    const double k = rint(a * INV_TWO_PI); const double r = (a - k * TWO_PI) * 0.5;
    const double r2 = r * r;
    double sn = 1.0, cs = 1.0, ts = 1.0, tc = 1.0;
#pragma unroll
    for (int i = 1; i <= 12; ++i) { constexpr double one = 1.0; tc *= -r2 * (one / (double)((2 * i - 1) * (2 * i))); ts *= -r2 * (one / (double)((2 * i) * (2 * i + 1))); cs += tc; sn += ts; }
    sn *= r;
    s = (float)(2.0 * sn * cs); c = (float)(1.0 - 2.0 * sn * sn);
}
__device__ __forceinline__ void prologue_phase(const Params& p, LAS unsigned char* lds, int tid, int wave, int lane) {
    LAS float* scr = (LAS float*)(lds + wave * 16384);
    const int gw = blockIdx.x * 8 + wave, NGW = gridDim.x * 8;
    int base = 0;
    for (int m = 0; m < 16; ++m) {
        WDesc d; get_wdesc(p, m, d);
        const int nitems = (d.K / 64) * ((d.N + 31) / 32);
        int first = (gw - base % NGW + NGW) % NGW;
        for (int it = first; it < nitems; it += NGW) transpose_item(d, scr, it, lane);
        base += nitems;
    }
    float* tab = (float*)(p.ws + WS_ROPE);
    const int gt = blockIdx.x * NTHREADS + tid, NGT = gridDim.x * NTHREADS;
    const double LN_THETA = 9.210340371976182736;
    for (int e = gt; e < ROPE_N; e += NGT) {
        int nf, f, idx;
        if (e < RA_COL) { nf = 16; f = e & 15; idx = e >> 4; }
        else if (e < RR_ROW) { nf = 16; f = (e - RA_COL) & 15; idx = (e - RA_COL) >> 4; }
        else if (e < RR_COL) { nf = 64; f = (e - RR_ROW) & 63; idx = (e - RR_ROW) >> 6; }
        else { nf = 64; f = (e - RR_COL) & 63; idx = (e - RR_COL) >> 6; }
        const double inv = exp(-(double)f / (double)nf * LN_THETA);
        float c, s; sincos_d((double)idx * inv, c, s); tab[e] = c; tab[ROPE_N + e] = s;
    }
}
__device__ __forceinline__ void chunk_start_phase(const Params& p, int chunk, int do_start, int do_final, int wave, int lane) {
    const int gw = blockIdx.x * 8 + wave, NGW = gridDim.x * 8;
    float* ssq = (float*)(p.ws + WS_SSQ);
    if (do_start) {
        const float* xin = (chunk == 0) ? p.in[0] : p.in[1] + (size_t)(chunk - 1) * CH_ROWS * DM;
        bf16_t* xb = (bf16_t*)(p.ws + WS_XB);
        for (int r0 = 2 * gw; r0 < CH_ROWS; r0 += 2 * NGW) {
            f32x4 v[2][4];
#pragma unroll
            for (int q = 0; q < 2; ++q) { const f32x4* src = (const f32x4*)(xin + (size_t)(r0 + q) * DM) + lane;
#pragma unroll
                for (int j = 0; j < 4; ++j) v[q][j] = src[64 * j]; }
#pragma unroll
            for (int q = 0; q < 2; ++q) {
                u32x2* db = (u32x2*)(xb + (size_t)(r0 + q) * DM) + lane; float ss = 0.f;
#pragma unroll
                for (int j = 0; j < 4; ++j) { const f32x4 x = v[q][j]; u32x2 w; w.x = cvtpk(x[0], x[1]); w.y = cvtpk(x[2], x[3]); db[64 * j] = w; ss += (x[0] * x[0] + x[1] * x[1]) + (x[2] * x[2] + x[3] * x[3]); }
                ss = wave_sum(ss);
                if (lane < 16) ssq[(size_t)(chunk * CH_ROWS + r0 + q) * 16 + lane] = (lane == 0) ? ss : 0.f;
            }
        }
    }
    if (do_final) {
        const int pc = do_start ? chunk - 1 : chunk;
        const f32x4* g = (const f32x4*)p.in[4] + lane;
        f32x4 gv[4];
#pragma unroll
        for (int j = 0; j < 4; ++j) gv[j] = g[64 * j];
        for (int r0 = 2 * gw; r0 < CH_ROWS; r0 += 2 * NGW) {
            f32x4 v[2][4]; float sv[2];
#pragma unroll
            for (int q = 0; q < 2; ++q) { const size_t row = (size_t)pc * CH_ROWS + r0 + q; sv[q] = (lane < 16) ? ssq[row * 16 + lane] : 0.f; const f32x4* xr = (const f32x4*)(p.out + row * DM) + lane;
#pragma unroll
                for (int j = 0; j < 4; ++j) v[q][j] = xr[64 * j]; }
#pragma unroll
            for (int q = 0; q < 2; ++q) { const size_t row = (size_t)pc * CH_ROWS + r0 + q; const float rs = rsqrtf(wave_sum(sv[q]) * (1.0f / DM) + EPS); f32x4* xr = (f32x4*)(p.out + row * DM) + lane;
#pragma unroll
                for (int j = 0; j < 4; ++j) xr[64 * j] = v[q][j] * rs * gv[j]; }
        }
    }
}
constexpr int LDP_AB = 3072;
__device__ __forceinline__ void prep_phase(const Params& p, int j, int seq_len, int wave, int lane) {
    bf16_t* P = (bf16_t*)(p.ws + WS_BIG1);
    const float qg = p.in[7][j * 64 + lane], kg = p.in[8][j * 64 + lane];
    const float* cosA = (const float*)(p.ws + WS_ROPE); const float* sinA = cosA + 8192 * 32;
    const int gw = blockIdx.x * 8 + wave, NGW = gridDim.x * 8;
    for (int row = gw; row < CH_ROWS; row += NGW) {
        bf16_t* ptr = P + (size_t)row * LDP_AB + lane;
        float x[10];
#pragma unroll
        for (int hh = 0; hh < 10; ++hh) x[hh] = bf2f(ptr[hh * 64]);
        const int pos = row & (seq_len - 1);
        const float c = cosA[pos * 32 + (lane & 31)], s = sinA[pos * 32 + (lane & 31)];
#pragma unroll
        for (int hh = 0; hh < 10; ++hh) {
            const float ss = wave_sum(x[hh] * x[hh]);
            const float rs = rsqrtf(ss * (1.0f / 64.0f) + EPS);
            const float y = x[hh] * rs * ((hh < 8) ? qg : kg);
            const float pr = __shfl_xor(y, 32);
            float o = (lane < 32) ? (y * c - pr * s) : (y * c + pr * s);
            if (hh < 8) o *= 0.125f * LOG2E;
            x[hh] = o;
        }
#pragma unroll
        for (int hh = 0; hh < 10; ++hh) ptr[hh * 64] = f2bf(x[hh]);
    }
}

__device__ __forceinline__ void attn_softmax_tile(f32x16& s0, f32x16& s1, float& l_run) {
    float ps = 0.f;
#pragma unroll
    for (int i = 0; i < 16; ++i) { s0[i] = __builtin_amdgcn_exp2f(s0[i]); s1[i] = __builtin_amdgcn_exp2f(s1[i]); ps += s0[i] + s1[i]; }
    l_run += ps;
}
__device__ __forceinline__ void attn_store_tile(bf16_t* orow, const f32x16& o0, const f32x16& o1, float l_run) {
    l_run += __shfl_xor(l_run, 32);
    const float inv = 1.f / l_run;
#pragma unroll
    for (int g = 0; g < 4; ++g) {
        u32x2 w0; w0.x = cvtpk(o0[4 * g] * inv, o0[4 * g + 1] * inv); w0.y = cvtpk(o0[4 * g + 2] * inv, o0[4 * g + 3] * inv);
        u32x2 w1; w1.x = cvtpk(o1[4 * g] * inv, o1[4 * g + 1] * inv); w1.y = cvtpk(o1[4 * g + 2] * inv, o1[4 * g + 3] * inv);
        *(u32x2*)(orow + 8 * g) = w0; *(u32x2*)(orow + 32 + 8 * g) = w1;
    }
}
__device__ __forceinline__ void attn_unit(const bf16_t* P, bf16_t* MO, LAS unsigned char* lds, int seq_len, int b, int hk, int qb, int tid, int wave, int lane, float negC) {
    constexpr int LD = 72, LDV = 96, TK = 128;
    LAS bf16_t* Kl = (LAS bf16_t*)lds;
    LAS bf16_t* Vl = Kl + 2 * TK * LD;
    const int rowbase = b * seq_len;
    const int r = lane & 31, h = lane >> 5;
    const int hq = hk * 4 + (wave >> 1);
    const int tq = rowbase + qb * 128 + 64 * (wave & 1) + r;
    bf16x8 qfA[4], qfB[4];
#pragma unroll
    for (int s = 0; s < 4; ++s) { qfA[s] = *(const bf16x8*)(P + (size_t)tq * LDP_AB + hq * 64 + 16 * s + 8 * h); qfB[s] = *(const bf16x8*)(P + (size_t)(tq + 32) * LDP_AB + hq * 64 + 16 * s + 8 * h); }
    const int skey = tid >> 3, sch = tid & 7;
    const bf16_t* kp = P + (size_t)(rowbase + skey) * LDP_AB + 512 + hk * 64 + sch * 8;
    const bf16_t* vp = P + (size_t)(rowbase + skey) * LDP_AB + 640 + hk * 64 + sch * 8;
    u32x4 kr0 = *(const u32x4*)kp, vr0 = *(const u32x4*)vp;
    { const u32x4 kr1 = *(const u32x4*)(kp + (size_t)64 * LDP_AB), vr1 = *(const u32x4*)(vp + (size_t)64 * LDP_AB);
      *(LAS u32x4*)(Kl + skey * LD + sch * 8) = kr0; *(LAS u32x4*)(Vl + skey * LDV + sch * 8) = vr0;
      *(LAS u32x4*)(Kl + (skey + 64) * LD + sch * 8) = kr1; *(LAS u32x4*)(Vl + (skey + 64) * LDV + sch * 8) = vr1; }
    __syncthreads();
    float lA = 0.f, lB = 0.f;
    f32x16 oA0 = {}, oA1 = {}, oB0 = {}, oB1 = {};
    const int ntile = seq_len / TK;
    for (int it = 0; it < ntile; ++it) {
        const int cur = it & 1;
#pragma unroll 1
        for (int sub = 0; sub < 2; ++sub) {
            if (it + 1 < ntile) { const size_t off = (size_t)((it + 1) * TK + sub * 64) * LDP_AB; kr0 = *(const u32x4*)(kp + off); vr0 = *(const u32x4*)(vp + off); }
            const LAS bf16_t* Kc = Kl + (cur * TK + sub * 64) * LD; const LAS bf16_t* Vc = Vl + (cur * TK + sub * 64) * LDV;
            f32x16 sA0 = {}, sA1 = {}, sB0 = {}, sB1 = {};
#pragma unroll
            for (int s = 0; s < 4; ++s) {
                const bf16x8 k0 = lds_rows(Kc, LD, 0, 16 * s, lane), k1 = lds_rows(Kc, LD, 32, 16 * s, lane);
                sA0 = mfma32(k0, qfA[s], sA0); sA1 = mfma32(k1, qfA[s], sA1); sB0 = mfma32(k0, qfB[s], sB0); sB1 = mfma32(k1, qfB[s], sB1);
            }
            if (negC != 0.f) {
#pragma unroll
                for (int i = 0; i < 16; ++i) { sA0[i] += negC; sA1[i] += negC; sB0[i] += negC; sB1[i] += negC; }
            }
            attn_softmax_tile(sA0, sA1, lA);
            attn_softmax_tile(sB0, sB1, lB);
#pragma unroll
            for (int s = 0; s < 2; ++s) {
                const bf16x8 pA0 = pack8(sA0, s), pA1 = pack8(sA1, s), pB0 = pack8(sB0, s), pB1 = pack8(sB1, s);
                const bf16x8 v00 = lds_tr_perm(Vc, LDV, 16 * s, 0, lane), v01 = lds_tr_perm(Vc, LDV, 16 * s, 32, lane);
                oA0 = mfma32(v00, pA0, oA0); oA1 = mfma32(v01, pA0, oA1); oB0 = mfma32(v00, pB0, oB0); oB1 = mfma32(v01, pB0, oB1);
                const bf16x8 v10 = lds_tr_perm(Vc, LDV, 32 + 16 * s, 0, lane), v11 = lds_tr_perm(Vc, LDV, 32 + 16 * s, 32, lane);
                oA0 = mfma32(v10, pA1, oA0); oA1 = mfma32(v11, pA1, oA1); oB0 = mfma32(v10, pB1, oB0); oB1 = mfma32(v11, pB1, oB1);
            }
            if (it + 1 < ntile) {
                LAS bf16_t* Kn = Kl + ((cur ^ 1) * TK + sub * 64) * LD; LAS bf16_t* Vn = Vl + ((cur ^ 1) * TK + sub * 64) * LDV;
                *(LAS u32x4*)(Kn + skey * LD + sch * 8) = kr0; *(LAS u32x4*)(Vn + skey * LDV + sch * 8) = vr0;
            }
        }
        __syncthreads();
    }
    attn_store_tile(MO + (size_t)tq * 1024 + hq * 64 + 4 * h, oA0, oA1, lA);
    attn_store_tile(MO + (size_t)(tq + 32) * 1024 + hq * 64 + 4 * h, oB0, oB1, lB);
}

constexpr size_t ML_U = 64 * MiB, ML_N = 96 * MiB, ML_S = 97 * MiB;
__device__ __forceinline__ int ml_unit(int w, int nchunk) {
    const int pk = w >> 1, dir = w & 1, oc = pk % nchunk, sh = pk / nchunk;
    return (sh * 2 + dir) * nchunk + (dir ? nchunk - 1 - oc : oc);
}
__device__ __forceinline__ void mlstm_gate_load(const Params& p, int j, const float* gates, int rowbase, int seq_len, int c, int dir, int head, int l, LAS float* a_k, LAS float* b_l) {
    const float* gbias = p.in[6] + j * 16;
    const int tok = dir ? (seq_len - 1 - (c * 128 + l)) : (c * 128 + l);
    const float* g = gates + (size_t)(rowbase + tok) * 16;
    const float ig = g[(2 * dir) * 4 + head] + gbias[(2 * dir) * 4 + head];
    const float fp = g[(2 * dir + 1) * 4 + head] + gbias[(2 * dir + 1) * 4 + head];
    a_k[l] = ig; b_l[l] = logsigmoidf_(fp);
}
__device__ __forceinline__ void mlstm_local_phase(const Params& p, int j, LAS unsigned char* lds, int seq_len, int tid_in, int wave) {
    constexpr int LD = 136;
    const bf16_t* P = (const bf16_t*)(p.ws + WS_BIG1);
    const float* gates = (const float*)(p.ws + WS_GATES);
    LAS bf16_t* Kl = (LAS bf16_t*)lds; LAS bf16_t* Vl = Kl + 128 * LD;
    LAS float* fs = (LAS float*)(lds + 4 * 128 * LD * 2);
    LAS float* a_k = fs; LAS float* b_l = fs + 128; LAS float* wk = fs + 384; LAS float* npart = fs + 640;
    bf16_t* U = (bf16_t*)(p.ws + WS_BIG2 + ML_U); float* NL = (float*)(p.ws + WS_BIG2 + ML_N); float* SC = (float*)(p.ws + WS_BIG2 + ML_S);
    const int nchunk = seq_len / 128;
    const float* gbias = p.in[6] + j * 16;
    u32x4 pk[4], pv[4]; float pig = 0.f, pfp = 0.f;
#define MLL_LOAD(UU) do { const int c_ = (UU) % nchunk, sidx_ = (UU) / nchunk, dir_ = sidx_ & 1, head_ = (sidx_ >> 1) & 3, rowbase_ = (sidx_ >> 3) * seq_len; \
        _Pragma("unroll") for (int i = 0; i < 4; ++i) { const int piece = tid + NTHREADS * i, l = piece >> 4, ch = piece & 15; \
            const int tok = dir_ ? (seq_len - 1 - (c_ * 128 + l)) : (c_ * 128 + l); \
            const bf16_t* src = P + (size_t)(rowbase_ + tok) * LDP_AB + head_ * 128 + ch * 8; \
            pk[i] = *(const u32x4*)(src + 1280); pv[i] = *(const u32x4*)(src + 1792); } \
        if (tid < 128) { const int tok = dir_ ? (seq_len - 1 - (c_ * 128 + tid)) : (c_ * 128 + tid); const float* g = gates + (size_t)(rowbase_ + tok) * 16; \
            pig = g[(2 * dir_) * 4 + head_] + gbias[(2 * dir_) * 4 + head_]; pfp = g[(2 * dir_ + 1) * 4 + head_] + gbias[(2 * dir_ + 1) * 4 + head_]; } } while (0)
    const int upb = (1024 + gridDim.x - 1) / gridDim.x;
    { const int tid = tid_in; if ((int)blockIdx.x * upb < 1024) { const int u0_ = ml_unit(blockIdx.x * upb, nchunk); MLL_LOAD(u0_); } }
    for (int wi = 0; wi < upb && (int)blockIdx.x * upb + wi < 1024; ++wi) {
        const int uidx = ml_unit(blockIdx.x * upb + wi, nchunk);
        int tid = tid_in; asm volatile("" : "+v"(tid)); const int lane = tid & 63, r = lane & 31, h = lane >> 5;
#pragma unroll
        for (int i = 0; i < 4; ++i) {
            const int piece = tid + NTHREADS * i, l = piece >> 4, ch = piece & 15;
            *(LAS u32x4*)(Kl + l * LD + ch * 8) = pk[i];
            *(LAS u32x4*)(Vl + l * LD + ch * 8) = pv[i];
        }
        if (tid < 128) { a_k[tid] = pig; b_l[tid] = logsigmoidf_(pfp); }
        __syncthreads();
        if (wi + 1 < upb && (int)blockIdx.x * upb + wi + 1 < 1024) { const int un_ = ml_unit(blockIdx.x * upb + wi + 1, nchunk); MLL_LOAD(un_); }
        if (wave == 0) {
            const float lf0 = b_l[2 * lane], lf1 = b_l[2 * lane + 1], ig0 = a_k[2 * lane], ig1 = a_k[2 * lane + 1];
            const float s1 = lf0 + lf1; float x = s1;
#pragma unroll
            for (int off = 1; off < 64; off <<= 1) { const float y = __shfl_up(x, off); if (lane >= off) x += y; }
            const float excl = x - s1, b0 = excl + lf0, b1 = excl + s1;
            const float a0 = ig0 - b0, a1 = ig1 - b1;
            float mxx = fmaxf(a0, a1);
#pragma unroll
            for (int off = 1; off < 64; off <<= 1) mxx = fmaxf(mxx, __shfl_xor(mxx, off));
            wk[2 * lane] = __expf(a0 - mxx); wk[2 * lane + 1] = __expf(a1 - mxx);
            if (lane == 63) { SC[(size_t)uidx * 4 + 0] = mxx; SC[(size_t)uidx * 4 + 1] = b1; }
        }
        __syncthreads();
#pragma unroll
        for (int i = 0; i < 4; ++i) {
            const int piece = tid + NTHREADS * i, l = piece >> 4, ch = piece & 15;
            const float w = wk[l];
            u32x4 v = *(LAS u32x4*)(Vl + l * LD + ch * 8);
            v.x = cvtpk(bflo(v.x) * w, bfhi(v.x) * w); v.y = cvtpk(bflo(v.y) * w, bfhi(v.y) * w); v.z = cvtpk(bflo(v.z) * w, bfhi(v.z) * w); v.w = cvtpk(bflo(v.w) * w, bfhi(v.w) * w);
            *(LAS u32x4*)(Vl + l * LD + ch * 8) = v;
        }
        { const int d = tid & 127, kq = tid >> 7; float acc = 0.f;
#pragma unroll 8
          for (int k = kq * 32; k < kq * 32 + 32; ++k) acc += wk[k] * bf2f(Kl[k * LD + d]);
          npart[kq * 128 + d] = acc; }
        __syncthreads();
        {
            const int et = wave >> 1, dt0 = 2 * (wave & 1);
            f32x16 c0 = {}, c1 = {};
#pragma unroll
            for (int s = 0; s < 8; ++s) { const bf16x8 A = lds_tr(Vl, LD, 16 * s, 32 * et, lane);
                c0 = mfma32(A, lds_tr(Kl, LD, 16 * s, 32 * dt0, lane), c0); c1 = mfma32(A, lds_tr(Kl, LD, 16 * s, 32 * dt0 + 32, lane), c1); }
            bf16_t* Uu = U + (size_t)uidx * 16384;
#pragma unroll
            for (int g = 0; g < 4; ++g) {
                u32x2 w0; w0.x = cvtpk(c0[4 * g], c0[4 * g + 1]); w0.y = cvtpk(c0[4 * g + 2], c0[4 * g + 3]);
                u32x2 w1; w1.x = cvtpk(c1[4 * g], c1[4 * g + 1]); w1.y = cvtpk(c1[4 * g + 2], c1[4 * g + 3]);
                *(u32x2*)(Uu + (32 * dt0 + r) * 128 + 32 * et + 8 * g + 4 * h) = w0;
                *(u32x2*)(Uu + (32 * dt0 + 32 + r) * 128 + 32 * et + 8 * g + 4 * h) = w1;
            }
            if (tid < 128) NL[(size_t)uidx * 128 + tid] = (npart[tid] + npart[128 + tid]) + (npart[256 + tid] + npart[384 + tid]);
        }
        __syncthreads();
    }
#undef MLL_LOAD
}
__device__ __forceinline__ void mlstm_combine_phase(const Params& p, LAS unsigned char* lds, int seq_len, int tid) {
    unsigned* U = (unsigned*)(p.ws + WS_BIG2 + ML_U); float* NL = (float*)(p.ws + WS_BIG2 + ML_N); float* SC = (float*)(p.ws + WS_BIG2 + ML_S);
    LAS float* keepv = (LAS float*)lds; LAS float* scv = keepv + 64;
    const int nchunk = seq_len / 128, nscan = 1024 / nchunk;
    for (int sl = blockIdx.x; sl < nscan * 16; sl += gridDim.x) {
        const int sidx = sl >> 4, eb = sl & 15;
        const size_t u0 = (size_t)sidx * nchunk;
        if (tid < 64) {
            const float pmv = (tid < nchunk) ? SC[(u0 + tid) * 4 + 0] : 0.f, blv = (tid < nchunk) ? SC[(u0 + tid) * 4 + 1] : 0.f;
            float m = 0.f, mst = 0.f;
            for (int c = 0; c < nchunk; ++c) {
                const float pm = __shfl(pmv, c), bl = __shfl(blv, c);
                const float Ml = fmaxf(m, pm);
                if (tid == c) { keepv[c] = __expf(m - Ml); scv[c] = __expf(pm - Ml); mst = m; }
                m = bl + Ml;
            }
            if (tid < nchunk && eb == 0) SC[(u0 + tid) * 4 + 2] = mst;
        }
        __syncthreads();
        unsigned* up = U + u0 * 8192 + eb * 512 + tid;
        float C0 = 0.f, C1 = 0.f;
        for (int c0 = 0; c0 < nchunk; c0 += 8) {
            unsigned uu[8];
#pragma unroll
            for (int i = 0; i < 8; ++i) uu[i] = up[(size_t)(c0 + i) * 8192];
#pragma unroll
            for (int i = 0; i < 8; ++i) { up[(size_t)(c0 + i) * 8192] = cvtpk(C0, C1); const float kp = keepv[c0 + i], sc = scv[c0 + i]; C0 = kp * C0 + sc * bflo(uu[i]); C1 = kp * C1 + sc * bfhi(uu[i]); }
        }
        if (eb == 0 && tid < 128) {
            float* np = NL + u0 * 128 + tid; float nn = 0.f;
            for (int c0 = 0; c0 < nchunk; c0 += 8) {
                float nl[8];
#pragma unroll
                for (int i = 0; i < 8; ++i) nl[i] = np[(size_t)(c0 + i) * 128];
#pragma unroll
                for (int i = 0; i < 8; ++i) { np[(size_t)(c0 + i) * 128] = nn; nn = keepv[c0 + i] * nn + scv[c0 + i] * nl[i]; }
            }
        }
        __syncthreads();
    }
}
__device__ __forceinline__ void mlstm_out_phase(const Params& p, int j, LAS unsigned char* lds, int seq_len, int tid_in, int wave) {
    constexpr int LD = 136;
    const bf16_t* P = (const bf16_t*)(p.ws + WS_BIG1);
    const float* gates = (const float*)(p.ws + WS_GATES);
    LAS bf16_t* Ql = (LAS bf16_t*)lds; LAS bf16_t* Kl = Ql + 128 * LD; LAS bf16_t* Vl = Kl + 128 * LD; LAS bf16_t* Cl = Vl + 128 * LD;
    LAS float* fs = (LAS float*)(lds + 4 * 128 * LD * 2);
    LAS float* a_k = fs; LAS float* b_l = fs + 128; LAS float* M_l = fs + 256; LAS float* nvec = fs + 512; LAS float* scal = fs + 1152;
    const bf16_t* U = (const bf16_t*)(p.ws + WS_BIG2 + ML_U); const float* NL = (const float*)(p.ws + WS_BIG2 + ML_N); const float* SC = (const float*)(p.ws + WS_BIG2 + ML_S);
    const int nchunk = seq_len / 128;
    const float* gbias = p.in[6] + j * 16;
    u32x4 pq[4], pk[4], pv[4], pc[4]; float pig = 0.f, pfp = 0.f, pnv = 0.f, pm = 0.f;
#define MLO_LOAD(UU) do { const int c_ = (UU) % nchunk, sidx_ = (UU) / nchunk, dir_ = sidx_ & 1, head_ = (sidx_ >> 1) & 3, rowbase_ = (sidx_ >> 3) * seq_len; \
        _Pragma("unroll") for (int i = 0; i < 4; ++i) { const int piece = tid + NTHREADS * i, l = piece >> 4, ch = piece & 15; \
            const int tok = dir_ ? (seq_len - 1 - (c_ * 128 + l)) : (c_ * 128 + l); \
            const bf16_t* src = P + (size_t)(rowbase_ + tok) * LDP_AB + head_ * 128 + ch * 8; \
            pq[i] = *(const u32x4*)(src + 768); pk[i] = *(const u32x4*)(src + 1280); pv[i] = *(const u32x4*)(src + 1792); \
            pc[i] = *(const u32x4*)(U + (size_t)(UU) * 16384 + l * 128 + ch * 8); } \
        if (tid < 128) { const int tok = dir_ ? (seq_len - 1 - (c_ * 128 + tid)) : (c_ * 128 + tid); const float* g = gates + (size_t)(rowbase_ + tok) * 16; \
            pig = g[(2 * dir_) * 4 + head_] + gbias[(2 * dir_) * 4 + head_]; pfp = g[(2 * dir_ + 1) * 4 + head_] + gbias[(2 * dir_ + 1) * 4 + head_]; pnv = NL[(size_t)(UU) * 128 + tid]; } \
        pm = SC[(size_t)(UU) * 4 + 2]; } while (0)
    const int upb = (1024 + gridDim.x - 1) / gridDim.x;
    { const int tid = tid_in; if ((int)blockIdx.x * upb < 1024) { const int u0_ = ml_unit(blockIdx.x * upb, nchunk); MLO_LOAD(u0_); } }
    for (int wi = 0; wi < upb && (int)blockIdx.x * upb + wi < 1024; ++wi) {
        const int uidx = ml_unit(blockIdx.x * upb + wi, nchunk);
        int tid = tid_in; asm volatile("" : "+v"(tid)); const int lane = tid & 63, r = lane & 31, h = lane >> 5;
        const int c = uidx % nchunk, sidx = uidx / nchunk, dir = sidx & 1, head = (sidx >> 1) & 3, b = sidx >> 3;
        const int rowbase = b * seq_len;
        bf16_t* H = (bf16_t*)(p.ws + WS_BIG2 + (dir ? 48 : 32) * MiB);
#pragma unroll
        for (int i = 0; i < 4; ++i) {
            const int piece = tid + NTHREADS * i, l = piece >> 4, ch = piece & 15;
            *(LAS u32x4*)(Ql + l * LD + ch * 8) = pq[i]; *(LAS u32x4*)(Kl + l * LD + ch * 8) = pk[i];
            *(LAS u32x4*)(Vl + l * LD + ch * 8) = pv[i]; *(LAS u32x4*)(Cl + l * LD + ch * 8) = pc[i];
        }
        if (tid < 128) { a_k[tid] = pig; b_l[tid] = logsigmoidf_(pfp); nvec[tid] = pnv; }
        if (tid == 0) scal[0] = pm;
        __syncthreads();
        if (wi + 1 < upb && (int)blockIdx.x * upb + wi + 1 < 1024) { const int un_ = ml_unit(blockIdx.x * upb + wi + 1, nchunk); MLO_LOAD(un_); }
        if (wave == 0) {
            const float lf0 = b_l[2 * lane], lf1 = b_l[2 * lane + 1], ig0 = a_k[2 * lane], ig1 = a_k[2 * lane + 1];
            const float s1 = lf0 + lf1; float x = s1;
#pragma unroll
            for (int off = 1; off < 64; off <<= 1) { const float y = __shfl_up(x, off); if (lane >= off) x += y; }
            const float excl = x - s1, b0 = excl + lf0, b1 = excl + s1;
            const float a0 = ig0 - b0, a1 = ig1 - b1;
            float mxx = fmaxf(a0, a1);
#pragma unroll
            for (int off = 1; off < 64; off <<= 1) { const float y = __shfl_up(mxx, off); if (lane >= off) mxx = fmaxf(mxx, y); }
            float exm = __shfl_up(mxx, 1); if (lane == 0) exm = -1e30f;
            const float m_old = scal[0];
            b_l[2 * lane] = b0; b_l[2 * lane + 1] = b1; a_k[2 * lane] = a0; a_k[2 * lane + 1] = a1;
            M_l[2 * lane] = fmaxf(m_old, fmaxf(exm, a0)); M_l[2 * lane + 1] = fmaxf(m_old, mxx);
        }
        __syncthreads();
        {
            const int qb = wave & 3, eh = wave >> 2, l = 32 * qb + r;
            bf16x8 qf[8];
#pragma unroll
            for (int s = 0; s < 8; ++s) qf[s] = lds_rows(Ql, LD, 32 * qb, 16 * s, lane);
            const float M = M_l[l], m_old = scal[0], bl = b_l[l];
            const float interw = __expf(m_old - M);
            float qn = 0.f;
#pragma unroll
            for (int s = 0; s < 8; ++s)
#pragma unroll
                for (int jj = 0; jj < 8; ++jj) qn += bf2f((bf16_t)qf[s][jj]) * nvec[16 * s + 8 * h + jj];
            qn += __shfl_xor(qn, 32);
            f32x16 o0 = {}, o1 = {};
#pragma unroll
            for (int s = 0; s < 8; ++s) { o0 = mfma32(lds_tr(Cl, LD, 16 * s, eh * 64, lane), qf[s], o0); o1 = mfma32(lds_tr(Cl, LD, 16 * s, eh * 64 + 32, lane), qf[s], o1); }
#pragma unroll
            for (int i = 0; i < 16; ++i) { o0[i] *= interw; o1[i] *= interw; }
            float dsum = 0.f;
            for (int kt = 0; kt <= qb; ++kt) {
                f32x16 sa = {};
#pragma unroll
                for (int s = 0; s < 8; ++s) sa = mfma32(lds_rows(Kl, LD, 32 * kt, 16 * s, lane), qf[s], sa);
#pragma unroll
                for (int i = 0; i < 16; ++i) { const int k = 32 * kt + accrow(i, h); const float w = (k <= l) ? __expf(a_k[k] - M) * sa[i] : 0.f; dsum += w; sa[i] = w; }
#pragma unroll
                for (int s2 = 0; s2 < 2; ++s2) { const bf16x8 wf = pack8(sa, s2);
                    o0 = mfma32(lds_tr_perm(Vl, LD, 32 * kt + 16 * s2, eh * 64, lane), wf, o0);
                    o1 = mfma32(lds_tr_perm(Vl, LD, 32 * kt + 16 * s2, eh * 64 + 32, lane), wf, o1); }
            }
            dsum += __shfl_xor(dsum, 32);
            const float den = dsum + interw * qn;
            const float inv = 1.f / fmaxf(fabsf(den), __expf(-(bl + M)));
            const int tok = dir ? (seq_len - 1 - (c * 128 + l)) : (c * 128 + l);
            bf16_t* hrow = H + (size_t)(rowbase + tok) * 512 + head * 128 + eh * 64 + 4 * h;
#pragma unroll
            for (int g = 0; g < 4; ++g) {
                u32x2 w0; w0.x = cvtpk(o0[4 * g] * inv, o0[4 * g + 1] * inv); w0.y = cvtpk(o0[4 * g + 2] * inv, o0[4 * g + 3] * inv);
                u32x2 w1; w1.x = cvtpk(o1[4 * g] * inv, o1[4 * g + 1] * inv); w1.y = cvtpk(o1[4 * g + 2] * inv, o1[4 * g + 3] * inv);
                *(u32x2*)(hrow + 8 * g) = w0; *(u32x2*)(hrow + 32 + 8 * g) = w1;
            }
        }
        __syncthreads();
    }
#undef MLO_LOAD
}

__device__ __forceinline__ void mix_phase(const Params& p, int j, LAS unsigned char* lds, int seq_len, int tid, int wave, int lane) {
    mlstm_combine_phase(p, lds, seq_len, tid);
    const int nseq = CH_ROWS / seq_len;
    const bf16_t* P = (const bf16_t*)(p.ws + WS_BIG1); bf16_t* MO = (bf16_t*)(p.ws + WS_BIG2);
    const int nqb = seq_len / 128, units = nseq * nqb * 2;
    float negC;
    { float gq = fabsf(p.in[7][j * 64 + lane]), gk = fabsf(p.in[8][j * 64 + lane]);
#pragma unroll
      for (int o = 1; o < 64; o <<= 1) { gq = fmaxf(gq, __shfl_xor(gq, o)); gk = fmaxf(gk, __shfl_xor(gk, o)); }
      negC = -(64.0f * 0.125f * LOG2E * 1.03f) * gq * gk; if (negC > -60.f) negC = 0.f; }
    for (int u0 = blockIdx.x; u0 < units; u0 += gridDim.x) {
        int pair, qb;
        if (gridDim.x == 256) {
            const int x = u0 & 7, idx = u0 >> 3;
            if (nqb == 64) { pair = x >> 1; qb = (x & 1) * 32 + idx; } else { pair = 2 * x + (idx >> 4); qb = idx & 15; }
        } else { pair = u0 / nqb; qb = u0 % nqb; }
        attn_unit(P, MO, lds, seq_len, pair >> 1, pair & 1, qb, tid, wave, lane, negC);
    }
}

__device__ __forceinline__ void fin_ab_phase(const Params& p, int j, int wave, int lane) {
    const bf16_t* P = (const bf16_t*)(p.ws + WS_BIG1); bf16_t* MO = (bf16_t*)(p.ws + WS_BIG2);
    const bf16_t* hf = (const bf16_t*)(p.ws + WS_BIG2 + 32 * MiB); const bf16_t* hb = (const bf16_t*)(p.ws + WS_BIG2 + 48 * MiB);
    const float* gn = p.in[9] + j * 512;
    float g0[4], g1[4];
#pragma unroll
    for (int head = 0; head < 4; ++head) { g0[head] = gn[head * 128 + 2 * lane]; g1[head] = gn[head * 128 + 2 * lane + 1]; }
    const int gw = blockIdx.x * 8 + wave, NGW = gridDim.x * 8;
    for (int row = gw; row < CH_ROWS; row += NGW) {
        unsigned a[4], bb[4], mo[4];
#pragma unroll
        for (int head = 0; head < 4; ++head) {
            a[head] = *(const unsigned*)(hf + (size_t)row * 512 + head * 128 + 2 * lane); bb[head] = *(const unsigned*)(hb + (size_t)row * 512 + head * 128 + 2 * lane);
            mo[head] = *(const unsigned*)(P + (size_t)row * LDP_AB + 2304 + head * 128 + 2 * lane);
        }
#pragma unroll
        for (int head = 0; head < 4; ++head) {
            const float s0 = bflo(a[head]) + bflo(bb[head]), s1 = bfhi(a[head]) + bfhi(bb[head]);
            const float ss = wave_sum(s0 * s0 + s1 * s1);
            const float rs = rsqrtf(ss * (1.0f / 128.0f) + EPS);
            *(unsigned*)(MO + (size_t)row * 1024 + 512 + head * 128 + 2 * lane) = cvtpk(s0 * rs * g0[head] * sigmoidf_(bflo(mo[head])), s1 * rs * g1[head] * sigmoidf_(bfhi(mo[head])));
        }
    }
}
constexpr int LDP_R = 5120;
constexpr size_t QT_OFF = 160 * MiB;
__device__ __forceinline__ void ret_scan(const Params& p, int j, LAS unsigned char* lds, int seq_len, int u, int tid_in, int wave, int variant) {
    constexpr int LDK = 288, LDV = 72;
    const bf16_t* P = (const bf16_t*)(p.ws + WS_BIG1);
    const bf16_t* QT = (const bf16_t*)(p.ws + WS_BIG1 + QT_OFF);
    LAS bf16_t* Kl = (LAS bf16_t*)lds; LAS bf16_t* Vl = Kl + 128 * LDK; LAS bf16_t* Cl = Vl + 128 * LDV;
    const int slice = u & 7, dir = (u >> 3) & 1, head = (u >> 4) & 3, b = u >> 6;
    const int rowbase = b * seq_len;
    bf16_t* Y = (bf16_t*)(p.ws + WS_BIG2 + (dir ? 64 : 0) * MiB);
    const float lg = logsigmoidf_(p.in[12][j * 8 + dir * 4 + head]);
    const float cd = __expf(lg * 128.f);
    f32x16 cacc0 = {}, cacc1 = {};
    for (int i = tid_in; i < 256 * LDV / 2; i += NTHREADS) ((LAS unsigned*)Cl)[i] = 0u;
    const int nchunk = seq_len / 128;
    const int qb = wave & 3, etq = wave >> 2;
    const int etu = wave & 1, dt0 = (wave >> 1) * 2;
    u32x4 kr[8], vr[2]; bf16x8 qf[16];
#define RS_LOADKV(cc) do { _Pragma("unroll") for (int i = 0; i < 8; ++i) { const int piece = tid + NTHREADS * i, l = piece >> 5, ch = piece & 31; \
            const int tok = dir ? (seq_len - 1 - ((cc) * 128 + l)) : ((cc) * 128 + l); \
            kr[i] = *(const u32x4*)(P + (size_t)(rowbase + tok) * LDP_R + head * 256 + ch * 8); } \
        _Pragma("unroll") for (int i = 0; i < 2; ++i) { const int piece = tid + NTHREADS * i, l = piece >> 3, ch = piece & 7; \
            const int tok = dir ? (seq_len - 1 - ((cc) * 128 + l)) : ((cc) * 128 + l); \
            vr[i] = *(const u32x4*)(P + (size_t)(rowbase + tok) * LDP_R + 1024 + head * 512 + slice * 64 + ch * 8); } } while (0)
#define RS_STOREKV() do { _Pragma("unroll") for (int i = 0; i < 8; ++i) { const int piece = tid + NTHREADS * i, l = piece >> 5, ch = piece & 31; *(LAS u32x4*)(Kl + l * LDK + ch * 8) = kr[i]; } \
        _Pragma("unroll") for (int i = 0; i < 2; ++i) { const int piece = tid + NTHREADS * i, l = piece >> 3, ch = piece & 7; u32x4 v = vr[i]; const float w = __expf(lg * (float)(127 - l)); \
            v.x = cvtpk(bflo(v.x) * w, bfhi(v.x) * w); v.y = cvtpk(bflo(v.y) * w, bfhi(v.y) * w); v.z = cvtpk(bflo(v.z) * w, bfhi(v.z) * w); v.w = cvtpk(bflo(v.w) * w, bfhi(v.w) * w); \
            *(LAS u32x4*)(Vl + l * LDV + ch * 8) = v; } } while (0)
#define RS_LOADQ(cc) do { const int oc = dir ? (nchunk - 1 - (cc)) : (cc); const int cidx = (rowbase >> 7) + oc; const int qbo = dir ? 3 - qb : qb, ro = dir ? 31 - r : r; \
        const bf16_t* qsrc = QT + ((((size_t)cidx * 4 + head) * 4 + qbo) * 1024 + h * 32 + ro) * 8; \
        _Pragma("unroll") for (int s = 0; s < 16; ++s) qf[s] = *(const bf16x8*)(qsrc + s * 512); } while (0)
    {
        int tid = tid_in; asm volatile("" : "+v"(tid)); const int lane = tid & 63, r = lane & 31, h = lane >> 5;
        RS_LOADKV(0); RS_LOADQ(0); RS_STOREKV();
        if (nchunk > 1) RS_LOADKV(1);
    }
    __syncthreads();
    for (int c = 0; c < nchunk; ++c) {
        int tid = tid_in; asm volatile("" : "+v"(tid)); const int lane = tid & 63, r = lane & 31, h = lane >> 5;
        const bool more = (c + 1 < nchunk);
        {
            const int lq = 32 * qb + r;
            const int tokq = dir ? (seq_len - 1 - (c * 128 + lq)) : (c * 128 + lq);
            f32x16 o = {}, ob = {};
            if (!(variant & 2)) {
                bf16x8 fa[2][2];
#pragma unroll
                for (int i = 0; i < 2; ++i) fa[0][i] = lds_tr(Cl, LDV, 16 * i, 32 * etq, lane);
#pragma unroll
                for (int sb = 0; sb < 8; ++sb) {
                    if (sb < 7) {
#pragma unroll
                        for (int i = 0; i < 2; ++i) fa[(sb + 1) & 1][i] = lds_tr(Cl, LDV, 16 * (2 * (sb + 1) + i), 32 * etq, lane);
                    }
                    __builtin_amdgcn_sched_barrier(0);
                    o = mfma32(fa[sb & 1][0], qf[2 * sb + 0], o); ob = mfma32(fa[sb & 1][1], qf[2 * sb + 1], ob);
                    __builtin_amdgcn_sched_barrier(0);
                }
#pragma unroll
                for (int i = 0; i < 16; ++i) o[i] += ob[i];
            }
            const float qd = __expf(lg * (float)(lq + 1));
            bf16_t* yrow = Y + (size_t)(rowbase + tokq) * 2048 + head * 512 + slice * 64 + 32 * etq + 4 * h;
#pragma unroll
            for (int g = 0; g < 4; ++g) { u32x2 w0; w0.x = cvtpk(o[4 * g] * qd, o[4 * g + 1] * qd); w0.y = cvtpk(o[4 * g + 2] * qd, o[4 * g + 3] * qd); if (!(variant & 1)) *(u32x2*)(yrow + 8 * g) = w0; else if (w0.x == 0x12345678u && w0.y == 0x9abcdef0u) *(u32x2*)(yrow + 8 * g) = w0; }
        }
        if (more && !(variant & 8)) RS_LOADQ(c + 1);
#pragma unroll
        for (int i = 0; i < 16; ++i) { cacc0[i] *= cd; cacc1[i] *= cd; }
        if (!(variant & 4)) {
            bf16x8 fu[2][3];
            fu[0][0] = lds_tr(Vl, LDV, 0, 32 * etu, lane); fu[0][1] = lds_tr(Kl, LDK, 0, 32 * dt0, lane); fu[0][2] = lds_tr(Kl, LDK, 0, 32 * dt0 + 32, lane);
#pragma unroll
            for (int s = 0; s < 8; ++s) {
                if (s < 7) { fu[(s + 1) & 1][0] = lds_tr(Vl, LDV, 16 * (s + 1), 32 * etu, lane); fu[(s + 1) & 1][1] = lds_tr(Kl, LDK, 16 * (s + 1), 32 * dt0, lane); fu[(s + 1) & 1][2] = lds_tr(Kl, LDK, 16 * (s + 1), 32 * dt0 + 32, lane); }
                __builtin_amdgcn_sched_barrier(0);
                cacc0 = mfma32(fu[s & 1][0], fu[s & 1][1], cacc0); cacc1 = mfma32(fu[s & 1][0], fu[s & 1][2], cacc1);
                __builtin_amdgcn_sched_barrier(0);
            }
        }
        __syncthreads();
#pragma unroll
        for (int g = 0; g < 4; ++g) {
            u32x2 w0; w0.x = cvtpk(cacc0[4 * g], cacc0[4 * g + 1]); w0.y = cvtpk(cacc0[4 * g + 2], cacc0[4 * g + 3]);
            u32x2 w1; w1.x = cvtpk(cacc1[4 * g], cacc1[4 * g + 1]); w1.y = cvtpk(cacc1[4 * g + 2], cacc1[4 * g + 3]);
            *(LAS u32x2*)(Cl + (32 * dt0 + r) * LDV + 32 * etu + 8 * g + 4 * h) = w0;
            *(LAS u32x2*)(Cl + (32 * dt0 + 32 + r) * LDV + 32 * etu + 8 * g + 4 * h) = w1;
        }
        if (more) RS_STOREKV();
        if (c + 2 < nchunk && !(variant & 8)) RS_LOADKV(c + 2);
        __syncthreads();
    }
#undef RS_LOADKV
#undef RS_STOREKV
#undef RS_LOADQ
}
__device__ __forceinline__ void ret_scan_phase(const Params& p, int j, LAS unsigned char* lds, int seq_len, int tid, int wave, int lane, int variant) {
    const int units = (CH_ROWS / seq_len) * 64;
    if (gridDim.x == 256) {
        const int x = blockIdx.x & 7, idx = blockIdx.x >> 3;
        if (units == 128) { if (idx < 16) ret_scan(p, j, lds, seq_len, ((2 * x + (idx >> 3)) << 3) | (idx & 7), tid, wave, variant); }
        else for (int rr = 0; rr < 2; ++rr) ret_scan(p, j, lds, seq_len, ((8 * x + 4 * rr + (idx >> 3)) << 3) | (idx & 7), tid, wave, variant);
    } else
    for (int u = blockIdx.x; u < units; u += gridDim.x) ret_scan(p, j, lds, seq_len, u, tid, wave, variant);
}
__device__ __forceinline__ void ret_intra_phase(const Params& p, int j, LAS unsigned char* lds, int tid_in, int wave, int lane_in, bool dry) {
    constexpr int LDK = 264, LDVV = 288;
    const bf16_t* P = (const bf16_t*)(p.ws + WS_BIG1);
    bf16_t* Yf = (bf16_t*)(p.ws + WS_BIG2); const bf16_t* Yb = (const bf16_t*)(p.ws + WS_BIG2 + 64 * MiB);
    const float* gn = p.in[13] + j * 2048;
    LAS bf16_t* Kl = (LAS bf16_t*)lds; LAS bf16_t* Vl = Kl + 128 * LDK; LAS float* ssqp = (LAS float*)(lds + 128 * LDK * 2 + 128 * LDVV * 2);
    const int lb = wave & 1, eg = wave >> 1;
    for (int u = blockIdx.x; u < 1024; u += gridDim.x) {
        int tid = tid_in; asm volatile("" : "+v"(tid)); const int lane = tid & 63, r = lane & 31, h = lane >> 5;
        int qh = u & 1, head = (u >> 1) & 3, lc = u >> 3;
        if (gridDim.x == 256) { const int pi = (u & 255) + 256 * (u >> 9); qh = (u >> 8) & 1; head = pi & 3; lc = pi >> 2; }
        const int R0 = lc * 128;
        const float lgf = logsigmoidf_(p.in[12][j * 8 + head]), lgb = logsigmoidf_(p.in[12][j * 8 + 4 + head]);
        const int l = 64 * qh + 32 * lb + r;
        bf16x8 qf[16]; u32x4 kr[8], vr[8];
        { const bf16_t* qsrc = (const bf16_t*)(p.ws + WS_BIG1 + QT_OFF) + ((((size_t)lc * 4 + head) * 4 + (2 * qh + lb)) * 1024 + h * 32 + r) * 8;
#pragma unroll
          for (int s = 0; s < 16; ++s) qf[s] = *(const bf16x8*)(qsrc + s * 512); }
        const bf16_t* rowp = P + (size_t)(R0 + (tid >> 5)) * LDP_R + (tid & 31) * 8;
        const bool sameK = (gridDim.x == 256) && qh == 1;
        if (!sameK) {
#pragma unroll
            for (int i = 0; i < 8; ++i) kr[i] = *(const u32x4*)(rowp + (size_t)(16 * i) * LDP_R + head * 256);
        }
#pragma unroll
        for (int i = 0; i < 8; ++i) vr[i] = *(const u32x4*)(rowp + (size_t)(16 * i) * LDP_R + 1024 + head * 512);
        if (!sameK) {
#pragma unroll
            for (int i = 0; i < 8; ++i) *(LAS u32x4*)(Kl + ((tid >> 5) + 16 * i) * LDK + (tid & 31) * 8) = kr[i];
            __syncthreads();
        }
        bf16x8 wf[4][2];
#pragma unroll
        for (int kt = 0; kt < 4; ++kt) {
            f32x16 sa = {};
#pragma unroll
            for (int s = 0; s < 16; ++s) sa = mfma32(lds_rows(Kl, LDK, 32 * kt, 16 * s, lane), qf[s], sa);
#pragma unroll
            for (int i = 0; i < 16; ++i) { const int k = 32 * kt + accrow(i, h); const int diff = l - k; sa[i] *= (diff >= 0) ? __expf(lgf * (float)diff) : __expf(lgb * (float)(-diff)); }
            wf[kt][0] = pack8(sa, 0); wf[kt][1] = pack8(sa, 1);
        }
#pragma unroll
        for (int i = 0; i < 8; ++i) *(LAS u32x4*)(Vl + ((tid >> 5) + 16 * i) * LDVV + (tid & 31) * 8) = vr[i];
#pragma unroll
        for (int i = 0; i < 8; ++i) vr[i] = *(const u32x4*)(rowp + (size_t)(16 * i) * LDP_R + 1024 + head * 512 + 256);
        __syncthreads();
        f32x16 o[4] = {};
#pragma unroll
        for (int kt = 0; kt < 4; ++kt)
#pragma unroll
            for (int s2 = 0; s2 < 2; ++s2)
#pragma unroll
                for (int e2 = 0; e2 < 2; ++e2)
                    o[e2] = mfma32(lds_tr_perm(Vl, LDVV, 32 * kt + 16 * s2, eg * 64 + 32 * e2, lane), wf[kt][s2], o[e2]);
        __syncthreads();
#pragma unroll
        for (int i = 0; i < 8; ++i) *(LAS u32x4*)(Vl + ((tid >> 5) + 16 * i) * LDVV + (tid & 31) * 8) = vr[i];
        const size_t ybase = (size_t)(R0 + l) * 2048 + head * 512;
        u32x2 ya[16], yb[16];
#pragma unroll
        for (int ti = 0; ti < 4; ++ti)
#pragma unroll
            for (int g = 0; g < 4; ++g) {
                const int e = (ti >> 1) * 256 + eg * 64 + 32 * (ti & 1) + 8 * g + 4 * h;
                ya[ti * 4 + g] = *(const u32x2*)(Yf + ybase + e); yb[ti * 4 + g] = *(const u32x2*)(Yb + ybase + e);
            }
        __syncthreads();
#pragma unroll
        for (int kt = 0; kt < 4; ++kt)
#pragma unroll
            for (int s2 = 0; s2 < 2; ++s2)
#pragma unroll
                for (int e2 = 0; e2 < 2; ++e2)
                    o[2 + e2] = mfma32(lds_tr_perm(Vl, LDVV, 32 * kt + 16 * s2, eg * 64 + 32 * e2, lane), wf[kt][s2], o[2 + e2]);
        u32x2 rgv[16];
#pragma unroll
        for (int ti = 0; ti < 4; ++ti)
#pragma unroll
            for (int g = 0; g < 4; ++g) {
                const int e = (ti >> 1) * 256 + eg * 64 + 32 * (ti & 1) + 8 * g + 4 * h;
                rgv[ti * 4 + g] = *(const u32x2*)(P + (size_t)(R0 + l) * LDP_R + 3072 + head * 512 + e);
            }
        float ss = 0.f;
#pragma unroll
        for (int ti = 0; ti < 4; ++ti)
#pragma unroll
            for (int g = 0; g < 4; ++g) {
                const u32x2 a = ya[ti * 4 + g], bb = yb[ti * 4 + g];
                o[ti][4 * g + 0] += bflo(a.x) + bflo(bb.x); o[ti][4 * g + 1] += bfhi(a.x) + bfhi(bb.x); o[ti][4 * g + 2] += bflo(a.y) + bflo(bb.y); o[ti][4 * g + 3] += bfhi(a.y) + bfhi(bb.y);
                ss += (o[ti][4 * g] * o[ti][4 * g] + o[ti][4 * g + 1] * o[ti][4 * g + 1]) + (o[ti][4 * g + 2] * o[ti][4 * g + 2] + o[ti][4 * g + 3] * o[ti][4 * g + 3]);
            }
        ss += __shfl_xor(ss, 32);
        if (h == 0) ssqp[eg * 64 + 32 * lb + r] = ss;
        __syncthreads();
        const float tot = (ssqp[32 * lb + r] + ssqp[64 + 32 * lb + r]) + (ssqp[128 + 32 * lb + r] + ssqp[192 + 32 * lb + r]);
        const float rs = rsqrtf(tot * (1.0f / 512.0f) + EPS);
#pragma unroll
        for (int ti = 0; ti < 4; ++ti)
#pragma unroll
            for (int g = 0; g < 4; ++g) {
                const int e = (ti >> 1) * 256 + eg * 64 + 32 * (ti & 1) + 8 * g + 4 * h;
                const f32x4 gv = *(const f32x4*)(gn + head * 512 + e);
                const u32x2 rg = rgv[ti * 4 + g];
                const float g0 = bflo(rg.x), g1 = bfhi(rg.x), g2 = bflo(rg.y), g3 = bfhi(rg.y);
                u32x2 w; w.x = cvtpk(o[ti][4 * g] * rs * gv[0] * g0 * sigmoidf_(g0), o[ti][4 * g + 1] * rs * gv[1] * g1 * sigmoidf_(g1));
                w.y = cvtpk(o[ti][4 * g + 2] * rs * gv[2] * g2 * sigmoidf_(g2), o[ti][4 * g + 3] * rs * gv[3] * g3 * sigmoidf_(g3));
                if (!dry) *(u32x2*)(Yf + ybase + e) = w;
            }
        __syncthreads();
    }
}
__device__ __forceinline__ void act_fix_phase(const Params& p, int layer, int seq_len, int tid) {
    const bf16_t* SB = (const bf16_t*)(p.ws + WS_BIG1); bf16_t* ACT = (bf16_t*)(p.ws + WS_BIG2);
    const float* cw = p.in[16] + (size_t)layer * 3 * 2816; const float* cb = p.in[17] + (size_t)layer * 2816;
    const int gt = blockIdx.x * NTHREADS + tid, NGT = gridDim.x * NTHREADS;
    for (int it = gt; it < 512 * 352; it += NGT) {
        const int rr = it / 352, c = (it % 352) * 8;
        const int k = rr >> 1, last = rr & 1;
        const int row = 64 * k + (last ? 63 : 0);
        const int pos = row & (seq_len - 1);
        const bf16_t* sb = SB + (size_t)k * 4 * 5632 + c;
        u32x4 uv, g0, gm = {0u, 0u, 0u, 0u}, gp = {0u, 0u, 0u, 0u};
        if (last) { uv = *(const u32x4*)(sb + 1 * 5632); g0 = *(const u32x4*)(sb + 1 * 5632 + 2816); gm = *(const u32x4*)(sb + 0 * 5632 + 2816); if (pos < seq_len - 1) gp = *(const u32x4*)(sb + (4 + 2) * 5632 + 2816); }
        else { uv = *(const u32x4*)(sb + 2 * 5632); g0 = *(const u32x4*)(sb + 2 * 5632 + 2816); gp = *(const u32x4*)(sb + 3 * 5632 + 2816); if (pos > 0) gm = *(const u32x4*)(sb + (-4 + 1) * 5632 + 2816); }
        const f32x4 w0a = *(const f32x4*)(cw + c), w0b = *(const f32x4*)(cw + c + 4), w1a = *(const f32x4*)(cw + 2816 + c), w1b = *(const f32x4*)(cw + 2816 + c + 4);
        const f32x4 w2a = *(const f32x4*)(cw + 5632 + c), w2b = *(const f32x4*)(cw + 5632 + c + 4), ba = *(const f32x4*)(cb + c), bb = *(const f32x4*)(cb + c + 4);
        float y[8];
#pragma unroll
        for (int q = 0; q < 4; ++q) {
            const unsigned a = (q == 0) ? gm.x : (q == 1) ? gm.y : (q == 2) ? gm.z : gm.w;
            const unsigned bq = (q == 0) ? g0.x : (q == 1) ? g0.y : (q == 2) ? g0.z : g0.w;
            const unsigned cq = (q == 0) ? gp.x : (q == 1) ? gp.y : (q == 2) ? gp.z : gp.w;
            const unsigned uq = (q == 0) ? uv.x : (q == 1) ? uv.y : (q == 2) ? uv.z : uv.w;
            const int e0 = 2 * q, e1 = 2 * q + 1;
            const float k00 = (e0 < 4) ? w0a[e0 & 3] : w0b[e0 & 3], k10 = (e0 < 4) ? w1a[e0 & 3] : w1b[e0 & 3], k20 = (e0 < 4) ? w2a[e0 & 3] : w2b[e0 & 3], b0 = (e0 < 4) ? ba[e0 & 3] : bb[e0 & 3];
            const float k01 = (e1 < 4) ? w0a[e1 & 3] : w0b[e1 & 3], k11 = (e1 < 4) ? w1a[e1 & 3] : w1b[e1 & 3], k21 = (e1 < 4) ? w2a[e1 & 3] : w2b[e1 & 3], b1 = (e1 < 4) ? ba[e1 & 3] : bb[e1 & 3];
            const float y0 = bflo(a) * k00 + bflo(bq) * k10 + bflo(cq) * k20 + b0;
            const float y1 = bfhi(a) * k01 + bfhi(bq) * k11 + bfhi(cq) * k21 + b1;
            y[e0] = gelu_as(y0) * bflo(uq); y[e1] = gelu_as(y1) * bfhi(uq);
        }
        u32x4 w; w.x = cvtpk(y[0], y[1]); w.y = cvtpk(y[2], y[3]); w.z = cvtpk(y[4], y[5]); w.w = cvtpk(y[6], y[7]);
        *(u32x4*)(ACT + (size_t)row * 2816 + c) = w;
    }
}
typedef const __attribute__((address_space(4))) Params* KParamsPtr;
#if defined(__HIP_DEVICE_COMPILE__)
#define RELOAD_PARAMS() KParamsPtr kq_ = kp_; asm volatile("" : "+s"(kq_)); const Params p = *kq_
#else
#define RELOAD_PARAMS() const Params p = p_arg
#endif
__global__ void __launch_bounds__(NTHREADS) __attribute__((amdgpu_waves_per_eu(2, 2))) mega_fwd(Params p_arg) {
#if defined(__HIP_DEVICE_COMPILE__)
    const KParamsPtr kp_ = (KParamsPtr)__builtin_amdgcn_kernarg_segment_ptr();
#endif
    unsigned char* const ws_top = p_arg.ws;
    extern __shared__ __attribute__((aligned(16))) unsigned char lds_raw[];
    LAS unsigned char* lds = (LAS unsigned char*)lds_raw;
    cg::grid_group grid = cg::this_grid();
    const int tid0 = threadIdx.x;
    unsigned char* ws = ws_top;
    volatile LAS unsigned* bst = (volatile LAS unsigned*)(lds + LDS_BYTES - 64);
    if (tid0 < 16) bst[tid0] = 0u;
    __syncthreads();
    XcdBarrier bar = xcd_barrier_post((unsigned*)(ws + WS_CTL), bst);

    { RELOAD_PARAMS(); const int tid = tid0, lane = tid & 63, wave = __builtin_amdgcn_readfirstlane(tid >> 6); prologue_phase(p, lds, tid, wave, lane); chunk_start_phase(p, 0, 1, 0, wave, lane); }
    grid.sync();
    for (int chunk = 0; chunk < 3; ++chunk) {
        const int seq_len = (chunk == 0) ? 8192 : 2048;
        const size_t row0 = (size_t)chunk * CH_ROWS;
        { RELOAD_PARAMS(); int tid = tid0; asm volatile("" : "+v"(tid)); const int lane = tid & 63, wave = __builtin_amdgcn_readfirstlane(tid >> 6); if (chunk > 0) chunk_start_phase(p, chunk, 1, 1, wave, lane); }
        if (chunk > 0) xcd_barrier(bar);
        for (int layer = 0; layer < 4; ++layer) {
            const int j = layer >> 1; const bool even = (layer & 1) == 0;
            for (int step = 0; step < 8; ++step) {
                const bool isg = (step == 0 || step == 4 || step == 5 || step == 7);
                const int pbit = isg ? 1 : (step == 1 ? (even ? 0 : 4) : (step == 2 ? 0 : (step == 3 ? 0 : 8)));
                const int reps = (PROBE_MASK & pbit) ? 2 : 1;
                for (int rep = 0; rep < reps; ++rep) {
                RELOAD_PARAMS(); unsigned char* ws = p.ws;
                int tid = tid0; asm volatile("" : "+v"(tid)); const int lane = tid & 63, wave = __builtin_amdgcn_readfirstlane(tid >> 6);
                if (step == 0 || step == 4 || step == 5 || step == 7) {
                    pg8::Gemm g; EpiF E; int emode = 0;
                    E.O = (bf16_t*)(ws + WS_BIG1); E.ldo = 0; E.ssq = (const float*)(ws + WS_SSQ) + row0 * 16; E.gates = (float*)(ws + WS_GATES);
                    E.qt = (bf16_t*)(ws + WS_BIG1 + QT_OFF); E.colsub = 0; E.qn = p.in[7] + j * 64; E.kn = p.in[8] + j * 64; E.cosa = (const float*)(ws + WS_ROPE); E.sina = E.cosa + ROPE_N; E.act = (bf16_t*)(ws + WS_BIG2); E.sb = (bf16_t*)(ws + WS_BIG1); E.cw = p.in[16] + (size_t)layer * 3 * 2816; E.cb = p.in[17] + (size_t)layer * 2816; E.cosr = (const float*)(ws + WS_ROPE); E.sinr = E.cosr + ROPE_N; E.seqmask = seq_len - 1;
                    E.x = (step == 7 && layer == 3) ? p.out + row0 * DM : nullptr; E.xb = (bf16_t*)(ws + WS_XB); E.ssq_out = (float*)(ws + WS_SSQ) + row0 * 16;
                    g.M = CH_ROWS;
                    if (step == 0) {
                        g.A = (const pg8::bf16_t*)(ws + WS_XB); g.K = 1024;
                        if (even) { g.Bt = (const pg8::bf16_t*)(ws + W_ABIN + j * W_ABIN_SZ); g.N = 3072; emode = 0; E.ldo = 3072; }
                        else { g.Bt = (const pg8::bf16_t*)(ws + W_RETIN + j * W_RETIN_SZ); g.N = 6144; emode = 1; E.ldo = 5120; E.colsub = 1024; }
                    } else if (step == 4) {
                        g.A = (const pg8::bf16_t*)(ws + WS_BIG2); g.N = 1024; emode = 3;
                        if (even) { g.Bt = (const pg8::bf16_t*)(ws + W_ABOUT + j * W_ABOUT_SZ); g.K = 1024; }
                        else { g.Bt = (const pg8::bf16_t*)(ws + W_RETOUT + j * W_RETOUT_SZ); g.K = 2048; }
                    } else if (step == 5) {
                        g.A = (const pg8::bf16_t*)(ws + WS_XB); g.K = 1024; g.Bt = (const pg8::bf16_t*)(ws + W_UP + layer * W_UP_SZ); g.N = 5632; emode = 2; E.ldo = 5632;
                    } else {
                        g.A = (const pg8::bf16_t*)(ws + WS_BIG2); g.K = 2816; g.Bt = (const pg8::bf16_t*)(ws + W_DOWN + layer * W_DOWN_SZ); g.N = 1024; emode = 3;
                    }
                    pg8::StaticOrder S; S.init(g.M, g.N, (int)gridDim.x, (int)blockIdx.x);
                    if (emode == 0) { EpiT<0> ET; (EpiF&)ET = E; pg8::gemm_phase<EpiT<0>, pg8::StaticOrder, true, true>(lds, g, S, ET); }
                    else if (emode == 1) { EpiT<1> ET; (EpiF&)ET = E; pg8::gemm_phase<EpiT<1>, pg8::StaticOrder, true, true>(lds, g, S, ET); }
                    else if (emode == 2) { EpiT<2> ET; (EpiF&)ET = E; pg8::gemm_phase<EpiT<2>, pg8::StaticOrder, true, true>(lds, g, S, ET); }
                    else { EpiT<3> ET; (EpiF&)ET = E; pg8::gemm_phase<EpiT<3>, pg8::StaticOrder, true, true>(lds, g, S, ET); }
                } else if (step == 1) {
                    if (even) { mlstm_local_phase(p, j, lds, seq_len, tid, wave); if (PROBE_MASK & 2048) mlstm_local_phase(p, j, lds, seq_len, tid, wave); } else ret_scan_phase(p, j, lds, seq_len, tid, wave, lane, (rep == 0) ? 0 : PROBE_VAR);
                } else if (step == 2) {
                    if (even) mix_phase(p, j, lds, seq_len, tid, wave, lane); else { if (PROBE_MASK & 512) ret_intra_phase(p, j, lds, tid, wave, lane, true); ret_intra_phase(p, j, lds, tid, wave, lane, false); }
                } else if (step == 3) {
                    if (even) { mlstm_out_phase(p, j, lds, seq_len, tid, wave); if (PROBE_MASK & 256) mlstm_out_phase(p, j, lds, seq_len, tid, wave); xcd_barrier(bar); fin_ab_phase(p, j, wave, lane); if (PROBE_MASK & 1024) fin_ab_phase(p, j, wave, lane); } else break;
                } else {
                    act_fix_phase(p, layer, seq_len, tid);
                }
                xcd_barrier(bar);
                if (PROBE_MASK & 32) xcd_barrier(bar);
                }
            }
        }
    }
    { RELOAD_PARAMS(); int tid = tid0; asm volatile("" : "+v"(tid)); const int lane = tid & 63, wave = __builtin_amdgcn_readfirstlane(tid >> 6); chunk_start_phase(p, 2, 0, 1, wave, lane); }
}

extern "C" void kernel_launch(void* const* d_in, const int* in_sizes, int n_in, void* d_out, int out_size, void* d_ws, size_t ws_size, hipStream_t stream) {
    static int grid = 0;
    if (grid == 0) {
        if (n_in != 19 || out_size != TOT_ROWS * DM || ws_size < WS_CTL + CTL_BYTES) { fprintf(stderr, "kernel_launch: unexpected shapes / workspace (%d inputs, out %d, ws %zu)\n", n_in, out_size, ws_size); grid = -1; return; }
        int dev = 0, cus = 0, per_cu = 0;
        hipGetDevice(&dev); hipDeviceGetAttribute(&cus, hipDeviceAttributeMultiprocessorCount, dev);
        if (hipFuncSetAttribute((const void*)mega_fwd, hipFuncAttributeMaxDynamicSharedMemorySize, LDS_BYTES) != hipSuccess) { fprintf(stderr, "kernel_launch: hipFuncSetAttribute failed\n"); grid = -1; return; }
        hipOccupancyMaxActiveBlocksPerMultiprocessor(&per_cu, (const void*)mega_fwd, NTHREADS, LDS_BYTES);
        (void)hipGetLastError();
        if (per_cu < 1) per_cu = 1;
        grid = cus;
        if (grid > 256) grid = 256;
    }
    if (grid < 0) return;
    Params p{};
    for (int i = 0; i < 19; ++i) p.in[i] = (const float*)d_in[i];
    p.out = (float*)d_out; p.ws = (unsigned char*)d_ws;
    void* args[] = {&p};
    if (hipMemsetAsync((char*)d_ws + WS_CTL, 0, CTL_BYTES, stream) != hipSuccess) { fprintf(stderr, "kernel_launch: memset failed\n"); return; }
    hipError_t e = hipLaunchCooperativeKernel((const void*)mega_fwd, dim3(grid), dim3(NTHREADS), args, LDS_BYTES, stream);
    if (e != hipSuccess) fprintf(stderr, "cooperative launch failed: %s (grid %d)\n", hipGetErrorString(e), grid);
}
```
